# Optimizing an MI355X kernel written in HIP

```python
import jax, jax.numpy as jnp
from jax import lax
import numpy as np

D_MODEL = 1024
BATCH = 8
SEQ = 4096
DEPTH = 1
DEC_BATCH = 2
DEC_SEQ = 8192
PAST_LEN = 128

N_META = 16
N_FOURIER_GROUPS = 4
FOURIER_GROUP_DIM = D_MODEL // 8
FOURIER_DIM = N_FOURIER_GROUPS * FOURIER_GROUP_DIM
N_HEADS = 8
QK_NOPE_DIM = 128
QK_ROPE_DIM = 64
QK_HEAD_DIM = QK_NOPE_DIM + QK_ROPE_DIM
V_HEAD_DIM = 128
Q_LORA_RANK = D_MODEL // 2
KV_LORA_RANK = D_MODEL // 4
ATTN_DIM = N_HEADS * V_HEAD_DIM
D_FF = ((-(-8 * D_MODEL // 3) + 255) // 256) * 256
ROPE_THETA = 10000.0
NORM_EPS = 1e-6
Q_BLOCK = 128
ATTN_SCALE = QK_HEAD_DIM ** -0.5
IN_SPLITS = (
    FOURIER_DIM,
    FOURIER_DIM + Q_LORA_RANK,
    FOURIER_DIM + Q_LORA_RANK + KV_LORA_RANK,
    FOURIER_DIM + Q_LORA_RANK + KV_LORA_RANK + QK_ROPE_DIM,
    FOURIER_DIM + Q_LORA_RANK + KV_LORA_RANK + QK_ROPE_DIM + D_MODEL,
)
IN_PROJ_DIM = IN_SPLITS[-1] + D_MODEL

kernel_name = "fnet_mla_gated_hybrid_encoder"


def _rmsnorm(x, g):
    xf = x.astype(jnp.float32)
    y = xf * lax.rsqrt(jnp.mean(xf * xf, axis=-1, keepdims=True) + NORM_EPS)
    return (y * g.astype(jnp.float32)).astype(x.dtype)


def _rope_tables(length):
    inv = 1.0 / (ROPE_THETA ** (jnp.arange(0, QK_ROPE_DIM, 2, dtype=jnp.float32) / QK_ROPE_DIM))
    ang = jnp.arange(length, dtype=jnp.float32)[:, None] * inv[None, :]
    return jnp.cos(ang), jnp.sin(ang)


def _apply_rope(x, cos, sin):
    xf = x.astype(jnp.float32)
    x1, x2 = jnp.split(xf, 2, axis=-1)
    c = cos[None, :, None, :]
    s = sin[None, :, None, :]
    return jnp.concatenate([x1 * c - x2 * s, x2 * c + x1 * s], axis=-1).astype(x.dtype)


def _attend(q, k, v):
    s = jnp.einsum("bthd,blhd->bhtl", q, k).astype(jnp.float32) * ATTN_SCALE
    p = jax.nn.softmax(s, axis=-1)
    return jnp.einsum("bhtl,blhd->bthd", p.astype(v.dtype), v)


def _fourier_mixer(u):
    b, l, _ = u.shape
    ug = u.astype(jnp.float32).reshape(b, l, N_FOURIER_GROUPS, FOURIER_GROUP_DIM)
    yf = jnp.fft.fft2(ug, axes=(1, 3), norm="ortho").real
    return yf.reshape(b, l, FOURIER_DIM).astype(u.dtype)


def _mla_mixer(c_q, c_kv, k_r, cos, sin, q_norm_g, kv_norm_g, w_uq, w_ukv):
    b, l, _ = c_q.shape
    q = (_rmsnorm(c_q, q_norm_g) @ w_uq).reshape(b, l, N_HEADS, QK_HEAD_DIM)
    q_nope, q_rope = jnp.split(q, [QK_NOPE_DIM], axis=-1)
    kv = (_rmsnorm(c_kv, kv_norm_g) @ w_ukv).reshape(b, l, N_HEADS, QK_NOPE_DIM + V_HEAD_DIM)
    k_nope, v = jnp.split(kv, [QK_NOPE_DIM], axis=-1)
    k_rope = _apply_rope(k_r[:, :, None, :], cos, sin)
    q = jnp.concatenate([q_nope, _apply_rope(q_rope, cos, sin)], axis=-1)
    k = jnp.concatenate([k_nope, jnp.broadcast_to(k_rope, (b, l, N_HEADS, QK_ROPE_DIM))], axis=-1)
    meta_out = _attend(q[:, :N_META], k, v)
    s_real = l - N_META
    nb = s_real // Q_BLOCK
    qb = q[:, N_META:].reshape(b, nb, Q_BLOCK, N_HEADS, QK_HEAD_DIM).transpose(1, 0, 2, 3, 4)
    ob = lax.map(lambda qq: _attend(qq, k, v), qb)
    real_out = ob.transpose(1, 0, 2, 3, 4).reshape(b, s_real, ATTN_DIM)
    return jnp.concatenate([meta_out.reshape(b, N_META, ATTN_DIM), real_out], axis=1)


def _layer(x, cos, sin, norm1_g, w_in, q_norm_g, kv_norm_g, w_uq, w_ukv, w_fourier_out,
           w_attn_out, w_o, norm2_g, w_ffn_gate, w_ffn_up, w_ffn_down):
    h = _rmsnorm(x, norm1_g)
    z = h @ w_in
    u_f, c_q, c_kv, k_r, g_a, g_b = jnp.split(z, list(IN_SPLITS), axis=-1)
    y_a = _fourier_mixer(u_f) @ w_fourier_out
    y_b = _mla_mixer(c_q, c_kv, k_r, cos, sin, q_norm_g, kv_norm_g, w_uq, w_ukv) @ w_attn_out
    merged = jax.nn.sigmoid(g_a) * y_a + jax.nn.sigmoid(g_b) * y_b
    x = x + merged @ w_o
    h2 = _rmsnorm(x, norm2_g)
    return x + (jax.nn.silu(h2 @ w_ffn_gate) * (h2 @ w_ffn_up)) @ w_ffn_down


def _trunk(x, meta_tokens, norm1_g, w_in, q_norm_g, kv_norm_g, w_uq, w_ukv, w_fourier_out,
           w_attn_out, w_o, norm2_g, w_ffn_gate, w_ffn_up, w_ffn_down, final_norm_g):
    b = x.shape[0]
    meta = jnp.broadcast_to(meta_tokens.astype(x.dtype)[None], (b, N_META, D_MODEL))
    h = jnp.concatenate([meta, x], axis=1)
    cos, sin = _rope_tables(h.shape[1])
    for i in range(DEPTH):
        h = _layer(h, cos, sin, norm1_g[i], w_in[i], q_norm_g[i], kv_norm_g[i], w_uq[i], w_ukv[i],
                   w_fourier_out[i], w_attn_out[i], w_o[i], norm2_g[i], w_ffn_gate[i],
                   w_ffn_up[i], w_ffn_down[i])
    h = _rmsnorm(h, final_norm_g)
    return h[:, N_META:]


def setup_inputs(seed: int = 0) -> dict:
    key = jax.random.key(seed)
    ks = jax.random.split(key, 20)

    def w(k, shape, fan_in):
        return jax.random.normal(k, shape, jnp.float32) * (fan_in ** -0.5)

    def g(k, shape):
        return 1.0 + 0.02 * jax.random.normal(k, shape, jnp.float32)

    return {
        "x_prompt": jax.random.normal(ks[0], (BATCH, SEQ, D_MODEL), jnp.float32),
        "x_sample": jax.random.normal(ks[1], (DEC_BATCH, DEC_SEQ, D_MODEL), jnp.float32),
        "meta_tokens": jax.random.normal(ks[2], (N_META, D_MODEL), jnp.float32),
        "norm1_g": g(ks[3], (DEPTH, D_MODEL)),
        "w_in": w(ks[4], (DEPTH, D_MODEL, IN_PROJ_DIM), D_MODEL),
        "q_norm_g": g(ks[5], (DEPTH, Q_LORA_RANK)),
        "kv_norm_g": g(ks[6], (DEPTH, KV_LORA_RANK)),
        "w_uq": w(ks[7], (DEPTH, Q_LORA_RANK, N_HEADS * QK_HEAD_DIM), Q_LORA_RANK),
        "w_ukv": w(ks[8], (DEPTH, KV_LORA_RANK, N_HEADS * (QK_NOPE_DIM + V_HEAD_DIM)), KV_LORA_RANK),
        "w_fourier_out": w(ks[9], (DEPTH, FOURIER_DIM, D_MODEL), FOURIER_DIM),
        "w_attn_out": w(ks[10], (DEPTH, ATTN_DIM, D_MODEL), ATTN_DIM),
        "w_o": w(ks[11], (DEPTH, D_MODEL, D_MODEL), D_MODEL),
        "norm2_g": g(ks[12], (DEPTH, D_MODEL)),
        "w_ffn_gate": w(ks[13], (DEPTH, D_MODEL, D_FF), D_MODEL),
        "w_ffn_up": w(ks[14], (DEPTH, D_MODEL, D_FF), D_MODEL),
        "w_ffn_down": w(ks[15], (DEPTH, D_FF, D_MODEL), D_FF),
        "final_norm_g": g(ks[16], (D_MODEL,)),
    }


def reference(x_prompt, x_sample, meta_tokens, norm1_g, w_in, q_norm_g, kv_norm_g, w_uq, w_ukv,
              w_fourier_out, w_attn_out, w_o, norm2_g, w_ffn_gate, w_ffn_up, w_ffn_down,
              final_norm_g):
    y_prompt = _trunk(x_prompt, meta_tokens, norm1_g, w_in, q_norm_g, kv_norm_g, w_uq, w_ukv,
                      w_fourier_out, w_attn_out, w_o, norm2_g, w_ffn_gate, w_ffn_up, w_ffn_down,
                      final_norm_g)
    y_sample = _trunk(x_sample, meta_tokens, norm1_g, w_in, q_norm_g, kv_norm_g, w_uq, w_ukv,
                      w_fourier_out, w_attn_out, w_o, norm2_g, w_ffn_gate, w_ffn_up, w_ffn_down,
                      final_norm_g)
    return (y_prompt, y_sample)
```

```cpp
#include <hip/hip_runtime.h>
#include <hip/hip_cooperative_groups.h>
#include <cstdio>
#include <cstdint>
namespace cg = cooperative_groups;

#ifndef DBG
#define DBG 0
#define DBGZ(u) false
#endif
#ifndef MK_SINGLE
#define MK_SINGLE 1
#endif

#define LAS __attribute__((address_space(3)))
typedef unsigned short bf16_t;
typedef short bf16x8 __attribute__((ext_vector_type(8)));
typedef short s16x4 __attribute__((ext_vector_type(4)));
typedef float f32x4 __attribute__((ext_vector_type(4)));
typedef float f32x16 __attribute__((ext_vector_type(16)));
typedef unsigned u32x4 __attribute__((ext_vector_type(4)));
typedef unsigned u32x2 __attribute__((ext_vector_type(2)));

constexpr int TOK = 49152;
constexpr int NMETA = 16;
constexpr float EPS = 1e-6f;
constexpr float ATT_SCALE = 0.07216878364870322f;
constexpr int TH = 0, TM = 192, TC = 193, TS = 299, TWZ = 405, TWP = 417, XROWS = 421 * 256;
constexpr size_t O_ROPE = 0;
constexpr size_t O_RS   = 2101248;
constexpr size_t RS_STRIDE = 49408;
constexpr size_t O_WUQ  = O_RS + 4 * RS_STRIDE * 4;
constexpr size_t O_WUKV = O_WUQ + 1572864;
constexpr size_t O_WFO  = O_WUKV + 1048576;
constexpr size_t O_WAO  = O_WFO + 1048576;
constexpr size_t O_WO   = O_WAO + 2097152;
constexpr size_t O_WGU  = O_WO + 2097152;
constexpr size_t O_WD   = O_WGU + 11534336;
constexpr size_t O_X    = 28311552;
constexpr size_t O_BAR  = O_WD + 5767168;
static_assert(O_BAR + 3456 * 4 <= O_X, "small region");
constexpr size_t SZ_X   = (size_t)XROWS * 2048;
constexpr size_t O_GA   = O_X + SZ_X;
constexpr size_t O_KR   = O_GA + 100663296;
constexpr size_t O_CQ   = O_KR + 6455296;
constexpr size_t O_CKV  = O_CQ + 50331648;
constexpr size_t O_PTP  = O_CKV + 25296896;
constexpr size_t O_PTS  = O_PTP + 35651584;
constexpr size_t O_V    = O_PTP;
constexpr size_t WS_NEED = O_V + 103284736;
constexpr size_t O_DAP  = O_X;
constexpr size_t O_DAS  = O_X + 20054016;
constexpr size_t O_STASH = O_X + 100663296;
constexpr size_t O_QN   = O_X;
constexpr size_t O_KN   = O_X + 100663296;
constexpr size_t O_X1B  = O_CQ;
constexpr size_t O_ACT  = O_X;
constexpr size_t OO_GB = 0, OO_QR = 100663296, OO_YF = 150994944;

struct Params {
  const float *x_prompt, *x_sample, *meta, *norm1_g, *w_in, *q_norm_g, *kv_norm_g, *w_uq, *w_ukv, *w_fo, *w_ao, *w_o, *norm2_g, *w_gate, *w_up, *w_down, *final_g;
  float* out; unsigned char* ws;
};

typedef __bf16 bf16x2_t __attribute__((ext_vector_type(2)));
typedef float f32x2_t __attribute__((ext_vector_type(2)));
__device__ __forceinline__ unsigned cvt_pk_bf16(float lo, float hi) { f32x2_t v = {lo, hi}; bf16x2_t r = __builtin_convertvector(v, bf16x2_t); return __builtin_bit_cast(unsigned, r); }
__device__ __forceinline__ int tid_fresh() { int t = threadIdx.x; asm volatile("" : "+v"(t)); return t; }
__device__ __forceinline__ float bf_lo(unsigned w) { return __uint_as_float(w << 16); }
__device__ __forceinline__ float bf_hi(unsigned w) { return __uint_as_float(w & 0xffff0000u); }
__host__ __device__ __forceinline__ int perm32(int rho) { const int n = rho >> 4, i = rho & 15; return 8 * (i >> 2) + 4 * n + (i & 3); }
__host__ __device__ __forceinline__ int permP(int v) { return (v & ~31) + perm32(v & 31); }
__host__ __device__ __forceinline__ int ropeslot(int s) { return 32 * ((s >> 4) & 1) + 16 * (s >> 5) + (s & 15); }
__device__ __forceinline__ int tok_seq(int t) { return t < 32768 ? (t >> 12) : 8 + ((t - 32768) >> 13); }
__device__ __forceinline__ int tok_pos(int t) { return t < 32768 ? (t & 4095) : ((t - 32768) & 8191); }
__device__ __forceinline__ int seq_S(int q) { return q < 8 ? 4096 : 8192; }
__device__ __forceinline__ int seq_tb(int q) { return q < 8 ? q * 4096 : 32768 + (q - 8) * 8192; }
__device__ __forceinline__ int seq_kvb(int q) { return q < 8 ? q * 4224 : 33792 + (q - 8) * 8320; }
__device__ __forceinline__ int tok_kvrow(int t) { return t < 32768 ? (t >> 12) * 4224 + (t & 4095) : 33792 + ((t - 32768) >> 13) * 8320 + ((t - 32768) & 8191); }
__device__ __forceinline__ float sigmoidf_(float x) { return __builtin_amdgcn_rcpf(1.f + __expf(-x)); }
__device__ __forceinline__ u32x4 pack8(f32x4 a, f32x4 b) { u32x4 w; w.x = cvt_pk_bf16(a[0], a[1]); w.y = cvt_pk_bf16(a[2], a[3]); w.z = cvt_pk_bf16(b[0], b[1]); w.w = cvt_pk_bf16(b[2], b[3]); return w; }
__device__ __forceinline__ u32x2 pack4(f32x4 a) { u32x2 w; w.x = cvt_pk_bf16(a[0], a[1]); w.y = cvt_pk_bf16(a[2], a[3]); return w; }
__device__ __forceinline__ float dot4(f32x4 a) { return a[0] * a[0] + a[1] * a[1] + a[2] * a[2] + a[3] * a[3]; }
__device__ __forceinline__ float red_fq(float s) { s += __shfl_xor(s, 16); s += __shfl_xor(s, 32); return s; }

constexpr int BM = 256, BK = 64, HALF = 128, HTB = HALF * BK * 2, STAGE_BYTES = 8 * HTB, NXCD = 8, WGM = 8;
__device__ __forceinline__ int lds_byte(int r, int c) { const int st = (r >> 4) * 2 + (c >> 5), rr = r & 15, cc = c & 31, ob = rr * 64 + cc * 2; return st * 1024 + (ob ^ (((ob >> 9) & 1) << 5)); }
__device__ __forceinline__ void stage_rc(int b, int& R, int& C) { const int st = b / 1024, sb = b % 1024, swz = sb ^ (((sb >> 9) & 1) << 5); R = (st >> 1) * 16 + swz / 64; C = (st & 1) * 32 + (swz % 64) / 2; }
struct Unit { int pm, pn; };
struct Gemm { const bf16_t* A; const bf16_t* Bt; int K; };

struct SchedGrid {
  int nM, nN, nwg, G, c, pm0, pn0, wgm;
  __device__ void init(int nM_, int nN_, int G_, int c_, int pm0_ = 0, int pn0_ = 0, int wgm_ = WGM) { nM = nM_; nN = nN_; nwg = nM * nN; G = G_; c = c_; pm0 = pm0_; pn0 = pn0_; wgm = wgm_; }
  __device__ bool map(int L, Unit& u) const {
    if (L >= nwg) return false;
    int wgid = L; { const int q = nwg / NXCD, r = nwg % NXCD, xcd = wgid % NXCD, off = wgid / NXCD; wgid = (xcd < r ? xcd * (q + 1) : r * (q + 1) + (xcd - r) * q) + off; }
    const int nig = wgm * nN, gid = wgid / nig, fm = gid * wgm, gsz = (nM - fm) < wgm ? (nM - fm) : wgm;
    u.pm = pm0 + fm + ((wgid % nig) % gsz); u.pn = pn0 + (wgid % nig) / gsz; return true;
  }
  __device__ bool next(int i, Unit& u) const { return map(i * G + c, u); }
};
struct SchedGridRev : SchedGrid {
  __device__ bool next(int i, Unit& u) const { if (!map(i * G + c, u)) return false; u.pm = pm0 + nM - 1 - (u.pm - pm0); return true; }
};
struct SchedP2 {
  SchedGrid z; int G, c;
  __device__ void init(int G_, int c_) { G = G_; c = c_; z.init(192, 12, G_, c_, TH, TWZ, 4); }
  __device__ bool next(int i, Unit& u) const {
    const int L = i * G + c;
    if (L < 2304) return z.map(L, u);
    if (L < 2306) { u.pm = TM; u.pn = TWZ + 2 + (L - 2304); return true; }
    if (L < 2730) { const int idx = L - 2306, a = idx & 3, j = idx >> 2; u.pm = TWP + a; u.pn = (a < 2 ? TC : TS) + j; return true; }
    return false;
  }
};

template <class Epi, class Sched>
__device__ __forceinline__ void gemm_phase(LAS unsigned char* lds, const Gemm g, const Sched& S, const Epi& E) {
  const int tid = tid_fresh(), wid = __builtin_amdgcn_readfirstlane(tid >> 6), lane = tid & 63, wr = wid >> 2, wc = wid & 3, fr = lane & 15, fq = lane >> 4;
  const int K = g.K, nt = K / BK;
  unsigned voffA[2];
#pragma unroll
  for (int i = 0; i < 2; ++i) { int R, C; stage_rc(tid * 16 + i * 8192, R, C); voffA[i] = (unsigned)(R * K + C) * 2u; }
  const size_t kstep = (size_t)(BK * 2);
  const size_t hstep = (size_t)HALF * K * 2;
  const size_t tstep = 2 * hstep;
  const unsigned ldsw = (unsigned)wid * 1024u;
  const int aoff = lds_byte(wr * 64 + fr, fq * 8), boff = lds_byte(wc * 32 + fr, fq * 8);
#define PG8_SA(b, h) (((b) * 2 + (h)) * HTB)
#define PG8_SB(b, h) ((4 + (b) * 2 + (h)) * HTB)
#define PG8_STAGE(bufoff, gbase) do { _Pragma("unroll") for (int _i = 0; _i < 2; ++_i) \
    __builtin_amdgcn_global_load_lds((const unsigned*)((const char*)(gbase) + voffA[_i]), (LAS unsigned*)(lds + (bufoff) + ldsw + _i * 8192), 16, 0, 0); } while (0)
#define PG8_LDA(dst, b, h) do { _Pragma("unroll") for (int m = 0; m < 4; ++m) _Pragma("unroll") for (int k = 0; k < 2; ++k) dst[m][k] = *(const LAS bf16x8*)(lds + PG8_SA(b, h) + aoff + m * 2048 + k * 1024); } while (0)
#define PG8_LDB(dst, b, h) do { _Pragma("unroll") for (int n = 0; n < 2; ++n) _Pragma("unroll") for (int k = 0; k < 2; ++k) dst[n][k] = *(const LAS bf16x8*)(lds + PG8_SB(b, h) + boff + n * 2048 + k * 1024); } while (0)
#define PG8_MMA(ai, bj, At, Bt) do { __builtin_amdgcn_s_setprio(1); _Pragma("unroll") for (int m = 0; m < 4; ++m) _Pragma("unroll") for (int n = 0; n < 2; ++n) _Pragma("unroll") for (int k = 0; k < 2; ++k) \
    acc[ai][bj][m][n] = __builtin_amdgcn_mfma_f32_16x16x32_bf16(Bt[n][k], At[m][k], acc[ai][bj][m][n], 0, 0, 0); __builtin_amdgcn_s_setprio(0); } while (0)
#define PG8_WAIT_V(n) asm volatile("s_waitcnt vmcnt(" #n ")" ::: "memory")
#define PG8_WAIT_L(n) asm volatile("s_waitcnt lgkmcnt(" #n ")" ::: "memory")
#define PG8_BAR __builtin_amdgcn_s_barrier()
#define PG8_SCHED __builtin_amdgcn_sched_barrier(0)
  Unit cur, nxt; int ui = 0;
  if (!S.next(0, cur)) return;
  f32x4 acc[2][2][4][2];
#pragma unroll
  for (int a = 0; a < 2; ++a)
#pragma unroll
    for (int b = 0; b < 2; ++b)
#pragma unroll
      for (int m = 0; m < 4; ++m)
#pragma unroll
        for (int n = 0; n < 2; ++n) acc[a][b][m][n] = (f32x4){0.f, 0.f, 0.f, 0.f};
  bf16x8 At[4][2], B0[2][2], B1[2][2];
  const char* cA = (const char*)g.A + (size_t)cur.pm * tstep; const char* cB = (const char*)g.Bt + (size_t)cur.pn * tstep;
  PG8_STAGE(PG8_SB(0, 0), cB); PG8_STAGE(PG8_SA(0, 0), cA); PG8_STAGE(PG8_SB(0, 1), cB + hstep); PG8_STAGE(PG8_SA(0, 1), cA + hstep);
  if (wr == 1) PG8_BAR;
  PG8_WAIT_V(4); PG8_BAR;
  PG8_STAGE(PG8_SB(1, 0), cB + kstep); PG8_STAGE(PG8_SA(1, 0), cA + kstep); PG8_STAGE(PG8_SB(1, 1), cB + hstep + kstep);
  PG8_WAIT_V(6); PG8_BAR;
  for (;;) {
    const bool has_next = S.next(ui + 1, nxt);
    const char* nA = has_next ? (const char*)g.A + (size_t)nxt.pm * tstep : cA; const char* nB = has_next ? (const char*)g.Bt + (size_t)nxt.pn * tstep : cB;
    for (int t = 0; t < nt; t += 2) {
      const bool last = (t == nt - 2);
      const char* a1 = cA + (size_t)(t + 1) * kstep;
      const char* a2 = last ? nA : cA + (size_t)(t + 2) * kstep; const char* b2 = last ? nB : cB + (size_t)(t + 2) * kstep;
      const char* a3 = a2 + kstep; const char* b3 = b2 + kstep;
      PG8_LDB(B0, 0, 0); PG8_SCHED; PG8_LDA(At, 0, 0); PG8_STAGE(PG8_SA(1, 1), a1 + hstep);
      PG8_WAIT_L(8); PG8_BAR; PG8_WAIT_L(0); PG8_MMA(0, 0, At, B0); PG8_BAR; PG8_SCHED;
      PG8_LDB(B1, 0, 1); PG8_STAGE(PG8_SB(0, 0), b2);
      PG8_BAR; PG8_WAIT_L(0); PG8_MMA(0, 1, At, B1); PG8_BAR;
      PG8_LDA(At, 0, 1); PG8_STAGE(PG8_SA(0, 0), a2);
      PG8_BAR; PG8_WAIT_L(0); PG8_MMA(1, 0, At, B0); PG8_BAR; PG8_SCHED;
      PG8_STAGE(PG8_SB(0, 1), b2 + hstep);
      PG8_WAIT_V(6); PG8_BAR; PG8_MMA(1, 1, At, B1); PG8_BAR;
      PG8_LDB(B0, 1, 0); PG8_SCHED; PG8_LDA(At, 1, 0); PG8_STAGE(PG8_SA(0, 1), a2 + hstep);
      PG8_WAIT_L(8); PG8_BAR; PG8_WAIT_L(0); PG8_MMA(0, 0, At, B0); PG8_BAR; PG8_SCHED;
      PG8_LDB(B1, 1, 1); PG8_STAGE(PG8_SB(1, 0), b3);
      PG8_BAR; PG8_WAIT_L(0); PG8_MMA(0, 1, At, B1); PG8_BAR;
      PG8_LDA(At, 1, 1); PG8_STAGE(PG8_SA(1, 0), a3);
      PG8_BAR; PG8_WAIT_L(0); PG8_MMA(1, 0, At, B0); PG8_BAR; PG8_SCHED;
      PG8_STAGE(PG8_SB(1, 1), b3 + hstep);
      PG8_WAIT_V(6); PG8_BAR; PG8_MMA(1, 1, At, B1); PG8_BAR;
    }
    E(acc, cur, wr, wc, fr, fq);
    if (!has_next) break;
#pragma unroll
    for (int a = 0; a < 2; ++a)
#pragma unroll
      for (int b = 0; b < 2; ++b)
#pragma unroll
        for (int m = 0; m < 4; ++m)
#pragma unroll
          for (int n = 0; n < 2; ++n) acc[a][b][m][n] = (f32x4){0.f, 0.f, 0.f, 0.f};
    cur = nxt; cA = nA; cB = nB; ++ui;
  }
  PG8_WAIT_V(0);
  if (wr == 0) PG8_BAR;
  PG8_BAR;
#undef PG8_SA
#undef PG8_SB
#undef PG8_STAGE
#undef PG8_LDA
#undef PG8_LDB
#undef PG8_MMA
#undef PG8_WAIT_V
#undef PG8_WAIT_L
#undef PG8_BAR
#undef PG8_SCHED
}

typedef const f32x4 (&AccRef)[2][2][4][2];

struct EpiZ {
  unsigned char* ws; unsigned char* outb;
  __device__ __forceinline__ void operator()(AccRef acc, const Unit& u, int wr, int wc, int fr, int fq) const {
    if (u.pm >= TWP) {
      const int a = u.pm - TWP, is_sin = a >> 1; const int j = u.pn - (is_sin ? TS : TC);
      int q, lt, Lk, rowlen; bf16_t* base;
      if (j < 72) { q = j / 9; lt = j - q * 9; Lk = 2176; rowlen = 2176; base = (bf16_t*)(ws + O_PTP) + (size_t)(is_sin * 4096 + q * 512) * 2176; }
      else { const int jj = j - 72; q = jj / 17; lt = jj - q * 17; Lk = 4224; rowlen = 4224; base = (bf16_t*)(ws + O_PTS) + (size_t)(is_sin * 1024 + q * 512) * 4224; }
      const int ch0 = (a & 1) * 256 + wr * 64 + fr, l0 = lt * 256 + wc * 32 + 4 * fq;
#pragma unroll
      for (int ai = 0; ai < 2; ++ai)
#pragma unroll
        for (int m = 0; m < 4; ++m) { bf16_t* rowp = base + (size_t)(ch0 + ai * 128 + m * 16) * rowlen + l0;
#pragma unroll
          for (int bj = 0; bj < 2; ++bj) if (lt * 256 + bj * 128 < Lk) {
#pragma unroll
            for (int n = 0; n < 2; ++n) *(u32x2*)(rowp + bj * 128 + n * 16) = pack4(acc[ai][bj][m][n]); } }
      return;
    }
    const int sec = u.pn - TWZ; const int row0 = u.pm * 256 + wr * 64 + fr;
    if (sec < 3) {
      bf16_t* dst; int ld, colb; float* rs;
      if (sec < 2) { dst = (bf16_t*)(ws + O_CQ); ld = 512; colb = sec * 256; rs = (float*)(ws + O_RS); }
      else { dst = (bf16_t*)(ws + O_CKV); ld = 256; colb = 0; rs = (float*)(ws + O_RS) + RS_STRIDE; }
#pragma unroll
      for (int ai = 0; ai < 2; ++ai)
#pragma unroll
        for (int m = 0; m < 4; ++m) { const int row = row0 + ai * 128 + m * 16; const bool valid = row < TOK + NMETA; float ss = 0.f;
#pragma unroll
          for (int bj = 0; bj < 2; ++bj) { ss += dot4(acc[ai][bj][m][0]) + dot4(acc[ai][bj][m][1]);
            if (valid) *(u32x4*)(dst + (size_t)row * ld + colb + bj * 128 + wc * 32 + 8 * fq) = pack8(acc[ai][bj][m][0], acc[ai][bj][m][1]); }
          ss = red_fq(ss); if (fq == 0 && valid) unsafeAtomicAdd(rs + row, ss); }
    } else if (sec == 3) {
      if (wc < 2) {
        const float* rope = (const float*)(ws + O_ROPE); bf16_t* KR = (bf16_t*)(ws + O_KR); const int j = 16 * wc + 4 * fq;
#pragma unroll
        for (int ai = 0; ai < 2; ++ai)
#pragma unroll
          for (int m = 0; m < 4; ++m) { const int row = row0 + ai * 128 + m * 16; if (row >= TOK + NMETA) continue;
            const int pos = row < TOK ? NMETA + tok_pos(row) : row - TOK;
            const f32x4 cs = *(const f32x4*)(rope + pos * 64 + j), sn = *(const f32x4*)(rope + pos * 64 + 32 + j);
            const f32x4 x1 = acc[ai][0][m][0], x2 = acc[ai][0][m][1];
            const u32x2 o1 = pack4(x1 * cs - x2 * sn), o2 = pack4(x2 * cs + x1 * sn);
            if (row < TOK) { bf16_t* d = KR + (size_t)tok_kvrow(row) * 64 + j; *(u32x2*)d = o1; *(u32x2*)(d + 32) = o2; }
            else { for (int q = 0; q < 10; ++q) { bf16_t* d = KR + (size_t)(seq_kvb(q) + seq_S(q) + (row - TOK)) * 64 + j; *(u32x2*)d = o1; *(u32x2*)(d + 32) = o2; } } }
      }
    } else {
      bf16_t* dst = sec < 8 ? (bf16_t*)(ws + O_GA) : (bf16_t*)(outb + OO_GB); const int colb = ((sec - 4) & 3) * 256 + wc * 32 + 8 * fq;
#pragma unroll
      for (int ai = 0; ai < 2; ++ai)
#pragma unroll
        for (int m = 0; m < 4; ++m) { const int row = row0 + ai * 128 + m * 16;
#pragma unroll
          for (int bj = 0; bj < 2; ++bj) { f32x4 a = acc[ai][bj][m][0], b = acc[ai][bj][m][1];
#pragma unroll
            for (int i = 0; i < 4; ++i) { a[i] = sigmoidf_(a[i]); b[i] = sigmoidf_(b[i]); }
            __builtin_nontemporal_store(pack8(a, b), (u32x4*)(dst + (size_t)row * 1024 + colb + bj * 128)); } }
    }
  }
};

struct SchedPair {
  int nMt, nNt, G, c, mode;
  __device__ bool next(int i, Unit& u) const {
    if ((G & 7) == 0) { const int x = c & 7, pl = (i >> 1) * (G >> 3) + (c >> 3);
      if (mode == 0) { if (pl >= 18) return false; u.pm = pl % 9; u.pn = 2 * x + pl / 9; }
      else { const int lo = (x >> 2) ? 9 : 0, cnt = (x >> 2) ? 8 : 9; if (pl >= cnt) return false; u.pm = lo + pl; u.pn = x & 3; } }
    else { const int pair = (i >> 1) * G + c; if (pair >= nMt * nNt) return false; u.pm = pair % nMt; u.pn = pair / nMt; }
    if (i & 1) { u.pm += nMt; u.pn += nNt; } return true;
  }
};
struct EpiDFT {
  bf16_t* YF; float* stash; int tb, S, nMt, nNt;
  __device__ __forceinline__ void operator()(AccRef acc, const Unit& u, int wr, int wc, int fr, int fq) const {
    const int tid = (wr * 4 + wc) * 64 + fq * 16 + fr; float* st = stash + (size_t)blockIdx.x * (512 * 128) + tid * 128;
    if (u.pm < nMt) {
#pragma unroll
      for (int ai = 0; ai < 2; ++ai)
#pragma unroll
        for (int bj = 0; bj < 2; ++bj)
#pragma unroll
          for (int m = 0; m < 4; ++m)
#pragma unroll
            for (int n = 0; n < 2; ++n) *(f32x4*)(st + (((ai * 2 + bj) * 4 + m) * 2 + n) * 4) = acc[ai][bj][m][n];
      return;
    }
    const int pn = u.pn - nNt, b = pn >> 1, col0 = (pn & 1) * 256 + wc * 32 + 8 * fq, half = (S + NMETA) >> 1; const int r0 = (u.pm - nMt) * 256 + wr * 64 + fr;
#pragma unroll
    for (int ai = 0; ai < 2; ++ai)
#pragma unroll
      for (int m = 0; m < 4; ++m) { const int k = r0 + ai * 128 + m * 16 + 1; if (k > half) continue;
#pragma unroll
        for (int bj = 0; bj < 2; ++bj) { const f32x4 c0 = *(const f32x4*)(st + (((ai * 2 + bj) * 4 + m) * 2 + 0) * 4), c1 = *(const f32x4*)(st + (((ai * 2 + bj) * 4 + m) * 2 + 1) * 4);
          const f32x4 s0 = acc[ai][bj][m][0], s1 = acc[ai][bj][m][1];
          if (k >= NMETA) *(u32x4*)(YF + (size_t)(tb + b * S + k - NMETA) * 512 + col0 + bj * 128) = pack8(c0 - s0, c1 - s1);
          if (k < half) *(u32x4*)(YF + (size_t)(tb + b * S + S - k) * 512 + col0 + bj * 128) = pack8(c0 + s0, c1 + s1);
          __builtin_amdgcn_sched_barrier(0); } }
  }
};

struct EpiQ {
  bf16_t* QN; bf16_t* QR; const float* rs; const float* rope;
  __device__ __forceinline__ void operator()(AccRef acc, const Unit& u, int wr, int wc, int fr, int fq) const {
    const int row0 = u.pm * 256 + wr * 64 + fr;
#pragma unroll
    for (int ai = 0; ai < 2; ++ai)
#pragma unroll
      for (int m = 0; m < 4; ++m) { const int row = row0 + ai * 128 + m * 16; const float rq = rsqrtf(rs[row] * (1.f / 512.f) + EPS); const int pos = NMETA + tok_pos(row);
#pragma unroll
        for (int bj = 0; bj < 2; ++bj) { const int beta = 4 * u.pn + 2 * bj + (wc >> 1), head = beta / 3, part = beta - 3 * head;
          if (part < 2) *(u32x4*)(QN + ((size_t)row * 8 + head) * 128 + part * 64 + (wc & 1) * 32 + 8 * fq) = pack8(acc[ai][bj][m][0] * rq, acc[ai][bj][m][1] * rq);
          else { const int j = 16 * (wc & 1) + 4 * fq; const f32x4 cs = *(const f32x4*)(rope + pos * 64 + j), sn = *(const f32x4*)(rope + pos * 64 + 32 + j);
            const f32x4 x1 = acc[ai][bj][m][0] * rq, x2 = acc[ai][bj][m][1] * rq; bf16_t* d = QR + ((size_t)row * 8 + head) * 64 + j;
            *(u32x2*)d = pack4(x1 * cs - x2 * sn); *(u32x2*)(d + 32) = pack4(x2 * cs + x1 * sn); } } }
  }
};

struct EpiKV {
  bf16_t* KN; bf16_t* V; const float* rs;
  __device__ __forceinline__ void operator()(AccRef acc, const Unit& u, int wr, int wc, int fr, int fq) const {
    const int row0 = u.pm * 256 + wr * 64 + fr, head = u.pn, col = wc * 32 + 8 * fq;
#pragma unroll
    for (int ai = 0; ai < 2; ++ai)
#pragma unroll
      for (int m = 0; m < 4; ++m) { const int row = row0 + ai * 128 + m * 16; if (row >= TOK + NMETA) continue;
        const float rk = rsqrtf(rs[row] * (1.f / 256.f) + EPS);
        const u32x4 kk = pack8(acc[ai][0][m][0] * rk, acc[ai][0][m][1] * rk), vv = pack8(acc[ai][1][m][0] * rk, acc[ai][1][m][1] * rk);
        if (row < TOK) { const size_t o = ((size_t)tok_kvrow(row) * 8 + head) * 128 + col; *(u32x4*)(KN + o) = kk; *(u32x4*)(V + o) = vv; }
        else { for (int q = 0; q < 10; ++q) { const size_t o = ((size_t)(seq_kvb(q) + seq_S(q) + (row - TOK)) * 8 + head) * 128 + col; *(u32x4*)(KN + o) = kk; *(u32x4*)(V + o) = vv; } } }
  }
};

struct EpiT1 {
  bf16_t* GA;
  __device__ __forceinline__ void operator()(AccRef acc, const Unit& u, int wr, int wc, int fr, int fq) const {
    const int row0 = u.pm * 256 + wr * 64 + fr, col0 = u.pn * 256 + wc * 32 + 8 * fq;
#pragma unroll
    for (int ai = 0; ai < 2; ++ai)
#pragma unroll
      for (int m = 0; m < 4; ++m) { bf16_t* rowp = GA + (size_t)(row0 + ai * 128 + m * 16) * 1024 + col0;
#pragma unroll
        for (int bj = 0; bj < 2; ++bj) { u32x4 g = *(const u32x4*)(rowp + bj * 128); const f32x4 a = acc[ai][bj][m][0], b = acc[ai][bj][m][1];
#if DBG == 10
          g = (u32x4){0x3f003f00u, 0x3f003f00u, 0x3f003f00u, 0x3f003f00u};
#endif
          const f32x4 ra = {bf_lo(g.x) * a[0], bf_hi(g.x) * a[1], bf_lo(g.y) * a[2], bf_hi(g.y) * a[3]}, rb = {bf_lo(g.z) * b[0], bf_hi(g.z) * b[1], bf_lo(g.w) * b[2], bf_hi(g.w) * b[3]};
#if DBG == 1
          *(u32x4*)(rowp + bj * 128) = (u32x4){0u, 0u, 0u, 0u};
#elif DBG >= 5
          *(u32x4*)(rowp + bj * 128) = DBGZ(u) ? (u32x4){0u, 0u, 0u, 0u} : pack8(ra, rb);
#else
          *(u32x4*)(rowp + bj * 128) = pack8(ra, rb);
#endif
          } }
  }
};
struct EpiMrg {
  bf16_t* GA; const bf16_t* GB;
  __device__ __forceinline__ void operator()(AccRef acc, const Unit& u, int wr, int wc, int fr, int fq) const {
    const int row0 = u.pm * 256 + wr * 64 + fr, col0 = u.pn * 256 + wc * 32 + 8 * fq;
#pragma unroll
    for (int ai = 0; ai < 2; ++ai)
#pragma unroll
      for (int m = 0; m < 4; ++m) { const size_t o = (size_t)(row0 + ai * 128 + m * 16) * 1024 + col0;
#pragma unroll
        for (int bj = 0; bj < 2; ++bj) { const u32x4 t = *(const u32x4*)(GA + o + bj * 128), g = *(const u32x4*)(GB + o + bj * 128); const f32x4 a = acc[ai][bj][m][0], b = acc[ai][bj][m][1];
          const f32x4 ra = {bf_lo(t.x) + bf_lo(g.x) * a[0], bf_hi(t.x) + bf_hi(g.x) * a[1], bf_lo(t.y) + bf_lo(g.y) * a[2], bf_hi(t.y) + bf_hi(g.y) * a[3]};
          const f32x4 rb = {bf_lo(t.z) + bf_lo(g.z) * b[0], bf_hi(t.z) + bf_hi(g.z) * b[1], bf_lo(t.w) + bf_lo(g.w) * b[2], bf_hi(t.w) + bf_hi(g.w) * b[3]};
#if DBG == 2
          *(u32x4*)(GA + o + bj * 128) = t;
#else
          *(u32x4*)(GA + o + bj * 128) = pack8(ra, rb);
#endif
          } }
  }
};
struct EpiX1 {
  const float* xp; const float* xs; bf16_t* X1B; float* rs;
  __device__ __forceinline__ void operator()(AccRef acc, const Unit& u, int wr, int wc, int fr, int fq) const {
    const int row0 = u.pm * 256 + wr * 64 + fr, col0 = u.pn * 256 + wc * 32 + 8 * fq;
#pragma unroll
    for (int ai = 0; ai < 2; ++ai)
#pragma unroll
      for (int m = 0; m < 4; ++m) { const int row = row0 + ai * 128 + m * 16; const float* xr = (row < 32768 ? xp + (size_t)row * 1024 : xs + (size_t)(row - 32768) * 1024) + col0; float ss = 0.f;
#pragma unroll
        for (int bj = 0; bj < 2; ++bj) { const f32x4 a = acc[ai][bj][m][0] + __builtin_nontemporal_load((const f32x4*)(xr + bj * 128)), b = acc[ai][bj][m][1] + __builtin_nontemporal_load((const f32x4*)(xr + bj * 128 + 4));
          ss += dot4(a) + dot4(b); const size_t o = (size_t)row * 1024 + col0 + bj * 128;
          *(u32x4*)(X1B + o) = pack8(a, b); }
        ss = red_fq(ss); if (fq == 0) unsafeAtomicAdd(rs + row, ss); }
  }
};
struct EpiFFN {
  bf16_t* ACT; const float* rs;
  __device__ __forceinline__ void operator()(AccRef acc, const Unit& u, int wr, int wc, int fr, int fq) const {
    const int row0 = u.pm * 256 + wr * 64 + fr, col0 = u.pn * 128 + wc * 32 + 8 * fq;
#pragma unroll
    for (int ai = 0; ai < 2; ++ai)
#pragma unroll
      for (int m = 0; m < 4; ++m) { const int row = row0 + ai * 128 + m * 16; const float r2 = rsqrtf(rs[row] * (1.f / 1024.f) + EPS); f32x4 o[2];
#pragma unroll
        for (int n = 0; n < 2; ++n)
#pragma unroll
          for (int i = 0; i < 4; ++i) { const float g = acc[ai][0][m][n][i] * r2, up = acc[ai][1][m][n][i] * r2; o[n][i] = g * sigmoidf_(g) * up; }
        *(u32x4*)(ACT + (size_t)row * 2816 + col0) = pack8(o[0], o[1]); }
  }
};
struct EpiX2 {
  bf16_t* X; float* rs;
  __device__ __forceinline__ void operator()(AccRef acc, const Unit& u, int wr, int wc, int fr, int fq) const {
    const int row0 = u.pm * 256 + wr * 64 + fr, col0 = u.pn * 256 + wc * 32 + 8 * fq;
#pragma unroll
    for (int ai = 0; ai < 2; ++ai)
#pragma unroll
      for (int m = 0; m < 4; ++m) { const int row = row0 + ai * 128 + m * 16; float ss = 0.f;
#pragma unroll
        for (int bj = 0; bj < 2; ++bj) { bf16_t* p = X + (size_t)row * 1024 + col0 + bj * 128; const u32x4 t = *(const u32x4*)p; const f32x4 a0 = acc[ai][bj][m][0], b0 = acc[ai][bj][m][1];
          const f32x4 a = {bf_lo(t.x) + a0[0], bf_hi(t.x) + a0[1], bf_lo(t.y) + a0[2], bf_hi(t.y) + a0[3]}, b = {bf_lo(t.z) + b0[0], bf_hi(t.z) + b0[1], bf_lo(t.w) + b0[2], bf_hi(t.w) + b0[3]};
          ss += dot4(a) + dot4(b); *(u32x4*)p = pack8(a, b); }
        ss = red_fq(ss); if (fq == 0) unsafeAtomicAdd(rs + row, ss); }
  }
};

constexpr int KVBLK = 64;
constexpr int SHM_V = 16384, SHM_KN = 64 * 272, SHM_KR = 64 * 144;
constexpr int A_V = 0, A_KN = 2 * SHM_V, A_KR = A_KN + 2 * SHM_KN, A_WS = A_KR + 2 * SHM_KR, A_QR = A_WS + 2048;
static_assert(A_QR + 8 * 4608 <= 131072, "attention LDS");
#define KNSWZ(row, colB) ((row) * 272 + (colB))
#define KRSWZ(row, colB) ((row) * 144 + (colB))
#define SBAR() __builtin_amdgcn_sched_barrier(0)
constexpr float THR = 8.f;
__device__ __forceinline__ int crow(int r, int hi) { return (r & 3) + 8 * (r >> 2) + 4 * hi; }
__device__ __forceinline__ void partialSM(f32x16& p0, f32x16& p1, float& m_reg, float& mn, float& alpha) {
  constexpr float C = ATT_SCALE * 1.4426950408889634f;
  float pmax = p0[0];
#pragma unroll
  for (int r = 1; r < 16; ++r) pmax = fmaxf(pmax, p0[r]);
#pragma unroll
  for (int r = 0; r < 16; ++r) pmax = fmaxf(pmax, p1[r]);
  { auto rr = __builtin_amdgcn_permlane32_swap(__float_as_uint(pmax), __float_as_uint(pmax), false, false);
    pmax = fmaxf(__uint_as_float(rr[0]), __uint_as_float(rr[1])); }
  if (__builtin_expect(__all(pmax - m_reg <= THR / ATT_SCALE), 1)) { mn = m_reg; alpha = 1.f; }
  else { mn = fmaxf(m_reg, pmax); alpha = __builtin_amdgcn_exp2f((m_reg - mn) * C); m_reg = mn; }
  const float mnC = -mn * C;
#pragma unroll
  for (int r = 0; r < 16; ++r) p0[r] = fmaf(p0[r], C, mnC);
#pragma unroll
  for (int r = 0; r < 16; ++r) p1[r] = fmaf(p1[r], C, mnC);
#pragma unroll
  for (int r = 0; r < 16; ++r) p0[r] = __builtin_amdgcn_exp2f(p0[r]);
}
__device__ __forceinline__ void finishSM(f32x16& p0, f32x16& p1, float alpha, float& l_reg, bf16x8& pa0, bf16x8& pa1, bf16x8& pa2, bf16x8& pa3) {
#pragma unroll
  for (int r = 0; r < 16; ++r) p1[r] = __builtin_amdgcn_exp2f(p1[r]);
  float ps = 0;
#pragma unroll
  for (int r = 0; r < 16; ++r) ps += p0[r];
#pragma unroll
  for (int r = 0; r < 16; ++r) ps += p1[r];
  { auto rr = __builtin_amdgcn_permlane32_swap(__float_as_uint(ps), __float_as_uint(ps), false, false);
    ps = __uint_as_float(rr[0]) + __uint_as_float(rr[1]); }
  l_reg = l_reg * alpha + ps;
#define PK4(P, BASE, OUT) do { unsigned a0 = cvt_pk_bf16(P[BASE + 0], P[BASE + 1]), a1 = cvt_pk_bf16(P[BASE + 2], P[BASE + 3]);   \
    unsigned b0 = cvt_pk_bf16(P[BASE + 4], P[BASE + 5]), b1 = cvt_pk_bf16(P[BASE + 6], P[BASE + 7]);                              \
    auto r0 = __builtin_amdgcn_permlane32_swap(a0, b0, false, false); auto r1 = __builtin_amdgcn_permlane32_swap(a1, b1, false, false); \
    u32x4 w = {r0[0], r1[0], r0[1], r1[1]}; OUT = *reinterpret_cast<bf16x8*>(&w); } while (0)
  PK4(p0, 0, pa0); PK4(p0, 8, pa1); PK4(p1, 0, pa2); PK4(p1, 8, pa3);
#undef PK4
}
__device__ __forceinline__ void qkt(f32x16& p0, f32x16& p1, const char* Kn, const char* Kr, const bf16x8* qr, const char* Qrl, int r32, int hi) {
  p0 = f32x16{}; p1 = f32x16{};
#pragma unroll
  for (int d0 = 0; d0 < 8; ++d0) { const int cb = (d0 * 16 + hi * 8) * 2;
    const bf16x8 b0 = *reinterpret_cast<const bf16x8*>(Kn + KNSWZ(r32, cb));
    const bf16x8 b1 = *reinterpret_cast<const bf16x8*>(Kn + KNSWZ(32 + r32, cb));
    p0 = __builtin_amdgcn_mfma_f32_32x32x16_bf16(b0, qr[d0], p0, 0, 0, 0);
    p1 = __builtin_amdgcn_mfma_f32_32x32x16_bf16(b1, qr[d0], p1, 0, 0, 0); }
#pragma unroll
  for (int d0 = 0; d0 < 4; ++d0) { const int cb = (d0 * 16 + hi * 8) * 2;
    const bf16x8 b0 = *reinterpret_cast<const bf16x8*>(Kr + KRSWZ(r32, cb));
    const bf16x8 b1 = *reinterpret_cast<const bf16x8*>(Kr + KRSWZ(32 + r32, cb));
    const bf16x8 qx = *reinterpret_cast<const bf16x8*>(Qrl + KRSWZ(r32, cb));
    p0 = __builtin_amdgcn_mfma_f32_32x32x16_bf16(b0, qx, p0, 0, 0, 0);
    p1 = __builtin_amdgcn_mfma_f32_32x32x16_bf16(b1, qx, p1, 0, 0, 0); }
}
__device__ __forceinline__ int v_st(int k, int c) { const int kk = (k & ~0xC) | ((k & 4) << 1) | ((k & 8) >> 1); return ((kk >> 3) * 4 + (c >> 5)) * 512 + ((kk & 7) * 32 + (c & 31)) * 2; }
__device__ __forceinline__ int v_rd_base(int lane) { return ((lane & 3) << 3) | (((lane >> 2) & 3) << 6) | (((lane >> 4) & 1) << 5) | (((lane >> 5) & 1) << 8); }
constexpr int v_rd_off(int d0, int ks, int half) { return d0 * 512 + ks * 4096 + half * 2048; }
template <int OFF> __device__ __forceinline__ s16x4 tr_read(int vb) {
  s16x4 r; asm volatile("ds_read_b64_tr_b16 %0, %1 offset:%2" : "=&v"(r) : "v"(vb), "i"(OFF) : "memory"); return r;
}
template <int D0> __device__ __forceinline__ void pv_one(f32x16& od, int vb, bf16x8 pa0, bf16x8 pa1, bf16x8 pa2, bf16x8 pa3) {
  const s16x4 l0 = tr_read<v_rd_off(D0, 0, 0)>(vb), h0 = tr_read<v_rd_off(D0, 0, 1)>(vb), l1 = tr_read<v_rd_off(D0, 1, 0)>(vb), h1 = tr_read<v_rd_off(D0, 1, 1)>(vb);
  const s16x4 l2 = tr_read<v_rd_off(D0, 2, 0)>(vb), h2 = tr_read<v_rd_off(D0, 2, 1)>(vb), l3 = tr_read<v_rd_off(D0, 3, 0)>(vb), h3 = tr_read<v_rd_off(D0, 3, 1)>(vb);
  asm volatile("s_waitcnt lgkmcnt(0)" ::: "memory"); SBAR();
#define PK(L, H) (bf16x8){L[0], L[1], L[2], L[3], H[0], H[1], H[2], H[3]}
  od = __builtin_amdgcn_mfma_f32_32x32x16_bf16(pa0, PK(l0, h0), od, 0, 0, 0);
  od = __builtin_amdgcn_mfma_f32_32x32x16_bf16(pa1, PK(l1, h1), od, 0, 0, 0);
  od = __builtin_amdgcn_mfma_f32_32x32x16_bf16(pa2, PK(l2, h2), od, 0, 0, 0);
  od = __builtin_amdgcn_mfma_f32_32x32x16_bf16(pa3, PK(l3, h3), od, 0, 0, 0);
#undef PK
}
__device__ __forceinline__ void pv_d0(f32x16* o, int vb, bf16x8 pa0, bf16x8 pa1, bf16x8 pa2, bf16x8 pa3) {
  pv_one<0>(o[0], vb, pa0, pa1, pa2, pa3); pv_one<1>(o[1], vb, pa0, pa1, pa2, pa3); pv_one<2>(o[2], vb, pa0, pa1, pa2, pa3); pv_one<3>(o[3], vb, pa0, pa1, pa2, pa3);
}

__device__ __forceinline__ void attn_body(const bf16_t* __restrict__ Qn, const bf16_t* __restrict__ Qr, const bf16_t* __restrict__ Kn, const bf16_t* __restrict__ Kr,
                                          const bf16_t* __restrict__ Vh, bf16_t* __restrict__ Ob, int NTP, char* lds) {
  const int tid = tid_fresh(), wid = tid >> 6, lane = tid & 63, r32 = lane & 31, hi = lane >> 5;
  char* V_lds = lds + A_V; char* KN_lds = lds + A_KN; char* KR_lds = lds + A_KR;
  float* wsl = (float*)(lds + A_WS) + wid * 64; float* li_l = wsl; float* al_l = wsl + 32;
  float m_reg = -1e30f, l_reg = 0; f32x16 o[4] = {}; bf16x8 qr[8]; char* Qrl = lds + A_QR + wid * 4608;
  { const bf16_t* Qw = Qn + (size_t)(wid * 32 + r32) * 1024 + hi * 8;
#pragma unroll
    for (int d0 = 0; d0 < 8; ++d0) qr[d0] = *reinterpret_cast<const bf16x8*>(Qw + d0 * 16);
    const bf16_t* Qw2 = Qr + (size_t)(wid * 32 + r32) * 512 + hi * 8;
#pragma unroll
    for (int d0 = 0; d0 < 4; ++d0) *reinterpret_cast<bf16x8*>(Qrl + KRSWZ(r32, (d0 * 16 + hi * 8) * 2)) = *reinterpret_cast<const bf16x8*>(Qw2 + d0 * 16); }
  const int sr = tid >> 4, sc = (tid & 15) * 8, vst0 = v_st(sr, sc), vst1 = v_st(32 + sr, sc);
  const int krr = tid >> 3, krc = (tid & 7) * 8;
  const int vb0 = (int)(uintptr_t)(LAS char*)V_lds + v_rd_base(lane);
  struct { bf16x8 vs0, vs1, ks0, ks1, kr; } sr_[1];
#define SLOAD(i, k0) do { sr_[i].vs0 = *(const bf16x8*)(&Vh[(size_t)((k0) + sr) * 1024 + sc]); sr_[i].vs1 = *(const bf16x8*)(&Vh[(size_t)((k0) + 32 + sr) * 1024 + sc]); \
    sr_[i].ks0 = *(const bf16x8*)(&Kn[(size_t)((k0) + sr) * 1024 + sc]); sr_[i].ks1 = *(const bf16x8*)(&Kn[(size_t)((k0) + 32 + sr) * 1024 + sc]); \
    sr_[i].kr = *(const bf16x8*)(&Kr[(size_t)((k0) + krr) * 64 + krc]); } while (0)
#define SWRITE(b, i) do { *(bf16x8*)(V_lds + (b) * SHM_V + vst0) = sr_[i].vs0; *(bf16x8*)(V_lds + (b) * SHM_V + vst1) = sr_[i].vs1; const int kc = sc * 2; \
    *(bf16x8*)(KN_lds + (b) * SHM_KN + KNSWZ(sr, kc)) = sr_[i].ks0; *(bf16x8*)(KN_lds + (b) * SHM_KN + KNSWZ(32 + sr, kc)) = sr_[i].ks1; \
    *(bf16x8*)(KR_lds + (b) * SHM_KR + KRSWZ(krr, krc * 2)) = sr_[i].kr; } while (0)
#define SWAIT() asm volatile("s_waitcnt vmcnt(0)" ::: "memory")
#define RESC(a) do { if (__any((a) < 1.f)) { if (hi == 0) al_l[r32] = (a); asm volatile("s_waitcnt lgkmcnt(0)" ::: "memory"); \
    _Pragma("unroll") for (int d = 0; d < 4; ++d) _Pragma("unroll") for (int r = 0; r < 16; ++r) o[d][r] *= al_l[crow(r, hi)]; } } while (0)
  f32x16 pA0, pA1, pB0, pB1; float mnA, mnB, alA, alB; bf16x8 pa0, pa1, pa2, pa3;
  constexpr int SE = 0, SO = 0;
  SLOAD(SE, 0); asm volatile("s_waitcnt vmcnt(0)" ::: "memory"); SWRITE(0, SE); __syncthreads();
  qkt(pA0, pA1, KN_lds, KR_lds, qr, Qrl, r32, hi); partialSM(pA0, pA1, m_reg, mnA, alA);
  SLOAD(SO, KVBLK);
  SWAIT(); SWRITE(1, SO); __syncthreads();
  for (int j = 1; j < NTP; j += 2) {
    SBAR(); qkt(pB0, pB1, KN_lds + SHM_KN, KR_lds + SHM_KR, qr, Qrl, r32, hi);
    finishSM(pA0, pA1, alA, l_reg, pa0, pa1, pa2, pa3); SBAR();
    SLOAD(SE, (j + 1) * KVBLK); SBAR();
    pv_d0(o, vb0, pa0, pa1, pa2, pa3); partialSM(pB0, pB1, m_reg, mnB, alB);
    __syncthreads(); SWAIT(); SWRITE(0, SE);
    RESC(alB); __syncthreads();
    SBAR(); qkt(pA0, pA1, KN_lds, KR_lds, qr, Qrl, r32, hi);
    if (j + 2 == NTP) {
#pragma unroll
      for (int r = 8; r < 16; ++r) pA0[r] = -1e30f;
#pragma unroll
      for (int r = 0; r < 16; ++r) pA1[r] = -1e30f;
    }
    finishSM(pB0, pB1, alB, l_reg, pa0, pa1, pa2, pa3); SBAR();
    SLOAD(SO, (j + 2) * KVBLK); SBAR();
    pv_d0(o, vb0 + SHM_V, pa0, pa1, pa2, pa3); partialSM(pA0, pA1, m_reg, mnA, alA);
    __syncthreads(); SWAIT(); SWRITE(1, SO);
    RESC(alA); __syncthreads();
  }
  finishSM(pA0, pA1, alA, l_reg, pa0, pa1, pa2, pa3); SBAR();
  pv_d0(o, vb0, pa0, pa1, pa2, pa3);
  if (hi == 0) li_l[r32] = l_reg; asm volatile("s_waitcnt lgkmcnt(0)" ::: "memory");
  float rli[16];
#pragma unroll
  for (int r = 0; r < 16; ++r) rli[r] = __builtin_amdgcn_rcpf(li_l[crow(r, hi)]);
  bf16_t* Ow = Ob + (size_t)(wid * 32) * 1024;
#pragma unroll
  for (int r = 0; r < 16; ++r) { const int orow = crow(r, hi);
#pragma unroll
    for (int d0 = 0; d0 < 4; ++d0) Ow[(size_t)orow * 1024 + d0 * 32 + r32] = (bf16_t)(cvt_pk_bf16(o[d0][r] * rli[r], 0.f) & 0xffffu); }
  asm volatile("s_waitcnt vmcnt(0)" ::: "memory");
  __syncthreads();
#undef SLOAD
#undef SWRITE
#undef SWAIT
#undef RESC
}

__device__ __forceinline__ float wave_sum(float v) {
#pragma unroll
  for (int o = 32; o > 0; o >>= 1) v += __shfl_xor(v, o);
  return v;
}

__device__ void conv_w(int mode, bf16_t* dst, int N, int K, const Params& p, int gtid, int gsize) {
  const int total = N * (K >> 3);
  for (int idx = gtid; idx < total; idx += gsize) {
    const int v = idx % N, k8 = idx / N;
    const float* src = nullptr; const float* scale = nullptr; int ld = 0, col = 0;
    switch (mode) {
      case 0: { ld = 3392; src = p.w_in; const int t = v >> 8;
        if (t < 2) col = 512 + permP(v); else if (t == 2) col = 1024 + permP(v - 512);
        else if (t == 3) { if (v - 768 < 64) col = 1280 + ropeslot(v - 768); else src = nullptr; }
        else if (t < 8) col = 1344 + permP(v - 1024); else col = 2368 + permP(v - 2048); } break;
      case 1: { ld = 1536; src = p.w_uq; scale = p.q_norm_g; const int beta = v >> 6; col = (beta % 3 < 2) ? permP(v) : (v & ~63) + ropeslot(v & 63); } break;
      case 2: ld = 2048; src = p.w_ukv; scale = p.kv_norm_g; col = permP(v); break;
      case 3: ld = 1024; src = p.w_fo; col = permP(v); break;
      case 4: ld = 1024; src = p.w_ao; col = permP(v); break;
      case 5: ld = 1024; src = p.w_o; col = permP(v); break;
      case 6: { ld = 2816; scale = p.norm2_g; const int t = v >> 8, half = (v >> 7) & 1, w = v & 127; src = half ? p.w_up : p.w_gate; col = t * 128 + permP(w); } break;
      default: ld = 1024; src = p.w_down; col = permP(v); break;
    }
    float f[8];
#pragma unroll
    for (int kk = 0; kk < 8; ++kk) { const int k = k8 * 8 + kk; f[kk] = src ? src[(size_t)k * ld + col] * (scale ? scale[k] : 1.f) : 0.f; }
    u32x4 w; w.x = cvt_pk_bf16(f[0], f[1]); w.y = cvt_pk_bf16(f[2], f[3]); w.z = cvt_pk_bf16(f[4], f[5]); w.w = cvt_pk_bf16(f[6], f[7]);
    *(u32x4*)(dst + (size_t)v * K + k8 * 8) = w;
  }
}

__device__ void phase_prep(const Params& p, unsigned char* smem) {
  const int gtid = blockIdx.x * 512 + threadIdx.x, gsize = gridDim.x * 512;
  unsigned char* ws = p.ws;
  { float* rs = (float*)(ws + O_RS); for (int i = gtid; i < 4 * (int)RS_STRIDE; i += gsize) rs[i] = 0.f; }
#if DBG == 9
  { u32x4* ga = (u32x4*)(ws + O_GA); for (int i = gtid; i < 100663296 / 16; i += gsize) ga[i] = (u32x4){0u, 0u, 0u, 0u}; }
#endif
  { float* rope = (float*)(ws + O_ROPE);
    for (int i = gtid; i < 8208 * 32; i += gsize) { const int pos = i >> 5, j = i & 31;
      const float inv = 1.0f / exp2f((float)(2 * j) * (1.f / 64.f) * 13.287712379549449f);
      const float ang = (float)pos * inv; const double rev = (double)ang * 0.15915494309189535; const float fr = (float)(rev - rint(rev));
      rope[pos * 64 + j] = __builtin_amdgcn_cosf(fr); rope[pos * 64 + 32 + j] = __builtin_amdgcn_sinf(fr); } }
  { float* tw = (float*)smem; __syncthreads();
    if (threadIdx.x < 256) { const int j = threadIdx.x & 127; const float ph = (float)j * (1.f / 128.f); tw[threadIdx.x] = threadIdx.x < 128 ? __builtin_amdgcn_cosf(ph) : __builtin_amdgcn_sinf(ph); }
    __syncthreads(); }
  const int wid = threadIdx.x >> 6; const int gt2 = (int)blockIdx.x * 128 + (threadIdx.x & 127), gs2 = (int)gridDim.x * 128;
  if (wid >= 2) {
  { bf16_t* X = (bf16_t*)(ws + O_X); const int lane = threadIdx.x & 63; const int gw = (int)blockIdx.x * 6 + (wid - 2), nw = (int)gridDim.x * 6;
    f32x4 g1[4];
#pragma unroll
    for (int i = 0; i < 4; ++i) g1[i] = *(const f32x4*)(p.norm1_g + 4 * (lane + 64 * i));
    for (int it = gw; it < 27136; it += nw) {
      int q, lp; if (it < 18432) { q = it / 2304; lp = it - q * 2304; } else { const int r = it - 18432; q = 8 + r / 4352; lp = r - (q - 8) * 4352; }
      const int S = seq_S(q), L = S + NMETA, half = L >> 1;
      bf16_t* hc = X + (size_t)(TC * 256 + it) * 1024; bf16_t* hs = X + (size_t)(TS * 256 + it) * 1024;
      if (lp > half) {
#pragma unroll
        for (int i = 0; i < 4; ++i) { *(u32x2*)(hc + 4 * (lane + 64 * i)) = (u32x2){0u, 0u}; *(u32x2*)(hs + 4 * (lane + 64 * i)) = (u32x2){0u, 0u}; }
        continue;
      }
      const bool single = (lp == 0) || (lp == half);
      const int l1 = lp, l2 = single ? lp : L - lp;
      const float* xa = l1 < NMETA ? p.meta + (size_t)l1 * 1024 : (q < 8 ? p.x_prompt + ((size_t)q * 4096 + (l1 - NMETA)) * 1024 : p.x_sample + ((size_t)(q - 8) * 8192 + (l1 - NMETA)) * 1024);
      const float* xb = l2 < NMETA ? p.meta + (size_t)l2 * 1024 : (q < 8 ? p.x_prompt + ((size_t)q * 4096 + (l2 - NMETA)) * 1024 : p.x_sample + ((size_t)(q - 8) * 8192 + (l2 - NMETA)) * 1024);
      f32x4 v1[4], v2[4]; float s1 = 0.f, s2 = 0.f;
#pragma unroll
      for (int i = 0; i < 4; ++i) { v1[i] = __builtin_nontemporal_load((const f32x4*)(xa + 4 * (lane + 64 * i))); v2[i] = __builtin_nontemporal_load((const f32x4*)(xb + 4 * (lane + 64 * i))); }
#pragma unroll
      for (int i = 0; i < 4; ++i) { s1 += dot4(v1[i]); s2 += dot4(v2[i]); }
#pragma unroll
      for (int o = 32; o > 0; o >>= 1) { s1 += __shfl_xor(s1, o); s2 += __shfl_xor(s2, o); }
      const float r1 = rsqrtf(s1 * (1.f / 1024.f) + EPS), r2 = rsqrtf(s2 * (1.f / 1024.f) + EPS);
#pragma unroll
      for (int i = 0; i < 4; ++i) { v1[i] = v1[i] * r1 * g1[i]; v2[i] = v2[i] * r2 * g1[i]; }
      bf16_t* h1 = nullptr; bf16_t* h2 = nullptr;
      if (l1 >= NMETA) h1 = X + (size_t)(seq_tb(q) + l1 - NMETA) * 1024; else if (q == 0) h1 = X + (size_t)(TM * 256 + l1) * 1024;
      if (!single) h2 = X + (size_t)(seq_tb(q) + l2 - NMETA) * 1024;
      if (h1) {
#pragma unroll
        for (int i = 0; i < 4; ++i) *(u32x2*)(h1 + 4 * (lane + 64 * i)) = pack4(v1[i]); }
      if (h2) {
#pragma unroll
        for (int i = 0; i < 4; ++i) *(u32x2*)(h2 + 4 * (lane + 64 * i)) = pack4(v2[i]); }
#pragma unroll
      for (int i = 0; i < 4; ++i) { const f32x4 c = single ? v1[i] : v1[i] + v2[i]; const f32x4 sn = single ? (f32x4){0.f, 0.f, 0.f, 0.f} : v1[i] - v2[i];
        *(u32x2*)(hc + 4 * (lane + 64 * i)) = pack4(c); *(u32x2*)(hs + 4 * (lane + 64 * i)) = pack4(sn); }
    }
  }
  } else {
  conv_w(0, (bf16_t*)(ws + O_X) + (size_t)TWZ * 256 * 1024, 3072, 1024, p, gt2, gs2);
  { float* tw = (float*)smem;
    bf16_t* WP = (bf16_t*)(ws + O_X) + (size_t)TWP * 256 * 1024;
    for (int idx = gt2; idx < 1024 * 1024; idx += gs2) { const int v = idx & 1023, k = idx >> 10; const int is_sin = v >> 9, c = permP(v & 511), g = c >> 7, cp = c & 127;
      const float* wr = p.w_in + (size_t)k * 3392 + g * 128; const float* T = tw + is_sin * 128; float acc0 = 0.f, acc1 = 0.f; int j = 0;
#pragma unroll 8
      for (int c0 = 0; c0 < 128; c0 += 2) { acc0 = fmaf(wr[c0], T[j], acc0); j = (j + cp) & 127; acc1 = fmaf(wr[c0 + 1], T[j], acc1); j = (j + cp) & 127; }
      WP[(size_t)v * 1024 + k] = (bf16_t)(cvt_pk_bf16(acc0 + acc1, 0.f) & 0xffffu); } }
  }
}

__device__ void phase_convw_late(const Params& p, int gtid, int gsize) {
  unsigned char* ws = p.ws;
  conv_w(1, (bf16_t*)(ws + O_WUQ), 1536, 512, p, gtid, gsize);
  conv_w(2, (bf16_t*)(ws + O_WUKV), 2048, 256, p, gtid, gsize);
  conv_w(3, (bf16_t*)(ws + O_WFO), 1024, 512, p, gtid, gsize);
  conv_w(4, (bf16_t*)(ws + O_WAO), 1024, 1024, p, gtid, gsize);
  conv_w(5, (bf16_t*)(ws + O_WO), 1024, 1024, p, gtid, gsize);
  conv_w(6, (bf16_t*)(ws + O_WGU), 5632, 1024, p, gtid, gsize);
  conv_w(7, (bf16_t*)(ws + O_WD), 1024, 2816, p, gtid, gsize);
}

template <int S, int LK, int MP>
__device__ __forceinline__ void dagen_grp(bf16_t* DA, bf16_t* tab) {
  constexpr int L = S + NMETA, half = L / 2, W8 = LK / 8, total = 2 * MP * W8;
  const int gtid = blockIdx.x * 512 + tid_fresh(), gsize = gridDim.x * 512;
  const float nrm = rsqrtf(128.f * (float)L), invL = 1.f / (float)L;
  __syncthreads();
  for (int m = threadIdx.x; m < L; m += 512) { const float ph = (float)m * invL;
    tab[m] = (bf16_t)(cvt_pk_bf16(__builtin_amdgcn_cosf(ph) * nrm, 0.f) & 0xffffu); tab[8208 + m] = (bf16_t)(cvt_pk_bf16(__builtin_amdgcn_sinf(ph) * nrm, 0.f) & 0xffffu); }
  __syncthreads();
  for (int idx = gtid; idx < total; idx += gsize) { const int r = idx / W8, c8 = idx - r * W8, part = r >= MP, k = r - part * MP + 1, lp0 = c8 * 8;
    int m = (k * lp0) % L; const bf16_t* T = tab + part * 8208; unsigned e[8];
#pragma unroll
    for (int j = 0; j < 8; ++j) { const int lp = lp0 + j; const bool valid = part ? (lp >= 1 && lp < half) : (lp <= half); e[j] = valid ? (unsigned)T[m] : 0u; m += k; m = m >= L ? m - L : m; }
    u32x4 w; w.x = e[0] | (e[1] << 16); w.y = e[2] | (e[3] << 16); w.z = e[4] | (e[5] << 16); w.w = e[6] | (e[7] << 16);
    *(u32x4*)(DA + (size_t)r * LK + lp0) = w; }
}
__device__ void phase_dagen(const Params& p, unsigned char* smem) {
  dagen_grp<4096, 2176, 2304>((bf16_t*)(p.ws + O_DAP), (bf16_t*)smem);
  dagen_grp<8192, 4224, 4352>((bf16_t*)(p.ws + O_DAS), (bf16_t*)smem);
}

__device__ void phase_attn(const Params& p, char* lds) {
  const int G = gridDim.x, c = blockIdx.x; const int cs = (G & 7) ? c : (c & 7) * (G >> 3) + (c >> 3);
  const bf16_t* QN = (const bf16_t*)(p.ws + O_QN); const bf16_t* QR = (const bf16_t*)((unsigned char*)p.out + OO_QR);
  const bf16_t* KN = (const bf16_t*)(p.ws + O_KN); const bf16_t* KR = (const bf16_t*)(p.ws + O_KR); const bf16_t* V = (const bf16_t*)(p.ws + O_V);
  for (int idx = cs; idx < 1536; idx += G) {
    int q, h, blk;
    if (idx < 512) { const int pair = idx >> 5; blk = idx & 31; q = 8 + (pair >> 3); h = pair & 7; }
    else { const int i2 = idx - 512, pair = i2 >> 4; blk = i2 & 15; q = pair >> 3; h = pair & 7; }
    const int S = seq_S(q); const size_t t0 = (size_t)seq_tb(q) + (size_t)blk * 256; const size_t kv0 = (size_t)seq_kvb(q);
    attn_body(QN + (t0 * 8 + h) * 128, QR + (t0 * 8 + h) * 64, KN + (kv0 * 8 + h) * 128, KR + kv0 * 64, V + (kv0 * 8 + h) * 128,
              (bf16_t*)(p.ws + O_QN) + (t0 * 8 + h) * 128, S / 64 + 1, lds);
  }
}

__device__ void phase_final(const Params& p) {
  const int lane = threadIdx.x & 63; const int gw = (blockIdx.x * 512 + threadIdx.x) >> 6, nw = (gridDim.x * 512) >> 6;
  const float* rs = (const float*)(p.ws + O_RS) + 3 * RS_STRIDE; const bf16_t* X2 = (const bf16_t*)(p.ws + O_X1B);
  f32x4 g[4];
#pragma unroll
  for (int i = 0; i < 4; ++i) g[i] = *(const f32x4*)(p.final_g + 4 * (lane + 64 * i));
  for (int t = gw; t < TOK; t += 2 * nw) { const int t2 = t + nw < TOK ? t + nw : t;
    const float ra = rsqrtf(rs[t] * (1.f / 1024.f) + EPS), rb = rsqrtf(rs[t2] * (1.f / 1024.f) + EPS);
    const bf16_t* xa = X2 + (size_t)t * 1024; const bf16_t* xb = X2 + (size_t)t2 * 1024; u32x2 wa[4], wb[4];
#pragma unroll
    for (int i = 0; i < 4; ++i) { wa[i] = *(const u32x2*)(xa + 4 * (lane + 64 * i)); wb[i] = *(const u32x2*)(xb + 4 * (lane + 64 * i)); }
#pragma unroll
    for (int i = 0; i < 4; ++i) { f32x4 v = {bf_lo(wa[i].x), bf_hi(wa[i].x), bf_lo(wa[i].y), bf_hi(wa[i].y)}; __builtin_nontemporal_store(v * ra * g[i], (f32x4*)(p.out + (size_t)t * 1024 + 4 * (lane + 64 * i))); }
    if (t2 != t) {
#pragma unroll
      for (int i = 0; i < 4; ++i) { f32x4 v = {bf_lo(wb[i].x), bf_hi(wb[i].x), bf_lo(wb[i].y), bf_hi(wb[i].y)}; __builtin_nontemporal_store(v * rb * g[i], (f32x4*)(p.out + (size_t)t2 * 1024 + 4 * (lane + 64 * i))); } } }
}

template <int PH>
__device__ __forceinline__ void run_phase(const Params& p, unsigned char* smem) {
  LAS unsigned char* lds = (LAS unsigned char*)smem; const int G = gridDim.x, c = blockIdx.x; unsigned char* ws = p.ws; unsigned char* outb = (unsigned char*)p.out;
  float* RS = (float*)(ws + O_RS);
  if constexpr (PH == 0) phase_prep(p, smem);
  if constexpr (PH == 1) { SchedP2 S; S.init(G, c); Gemm g{(const bf16_t*)(ws + O_X), (const bf16_t*)(ws + O_X), 1024}; EpiZ E{ws, outb}; gemm_phase(lds, g, S, E); }
  if constexpr (PH == 2) phase_dagen(p, smem);
  if constexpr (PH == 3) {
    const int hG = (G == 256) ? 112 : (G >> 1); float* stash = (float*)(ws + O_STASH);
    if (c < hG) { SchedPair S{17, 4, hG, c, 1}; Gemm g{(const bf16_t*)(ws + O_DAS), (const bf16_t*)(ws + O_PTS), 4224}; EpiDFT E{(bf16_t*)(outb + OO_YF), stash, 32768, 8192, 17, 4}; gemm_phase(lds, g, S, E); }
    else { SchedPair S{9, 16, G - hG, c - hG, 0}; Gemm g{(const bf16_t*)(ws + O_DAP), (const bf16_t*)(ws + O_PTP), 2176}; EpiDFT E{(bf16_t*)(outb + OO_YF), stash, 0, 4096, 9, 16}; gemm_phase(lds, g, S, E); }
    { int cg = c, cn = G; bool act = true;
      if (G == 256) { act = c >= hG; cg = c - hG; cn = G - hG; }
      if (act) phase_convw_late(p, cg * 512 + tid_fresh(), cn * 512); }
  }
  if constexpr (PH == 4) { SchedGrid S; S.init(192, 6, G, c); Gemm g{(const bf16_t*)(ws + O_CQ), (const bf16_t*)(ws + O_WUQ), 512}; EpiQ E{(bf16_t*)(ws + O_QN), (bf16_t*)(outb + OO_QR), RS, (const float*)(ws + O_ROPE)}; gemm_phase(lds, g, S, E); }
  if constexpr (PH == 11) { SchedGrid S; S.init(193, 8, G, c); Gemm g{(const bf16_t*)(ws + O_CKV), (const bf16_t*)(ws + O_WUKV), 256}; EpiKV E{(bf16_t*)(ws + O_KN), (bf16_t*)(ws + O_V), RS + RS_STRIDE}; gemm_phase(lds, g, S, E); }
  if constexpr (PH == 12) { SchedGrid S; S.init(192, 4, G, c); Gemm g{(const bf16_t*)(outb + OO_YF), (const bf16_t*)(ws + O_WFO), 512}; EpiT1 E{(bf16_t*)(ws + O_GA)}; gemm_phase(lds, g, S, E); }
  if constexpr (PH == 5) phase_attn(p, (char*)smem);
  if constexpr (PH == 6) { SchedGrid S; S.init(192, 4, G, c); Gemm g{(const bf16_t*)(ws + O_QN), (const bf16_t*)(ws + O_WAO), 1024}; EpiMrg E{(bf16_t*)(ws + O_GA), (const bf16_t*)(outb + OO_GB)}; gemm_phase(lds, g, S, E); }
  if constexpr (PH == 7) { SchedGrid S; S.init(192, 4, G, c); Gemm g{(const bf16_t*)(ws + O_GA), (const bf16_t*)(ws + O_WO), 1024}; EpiX1 E{p.x_prompt, p.x_sample, (bf16_t*)(ws + O_X1B), RS + 2 * RS_STRIDE}; gemm_phase(lds, g, S, E); }
  if constexpr (PH == 8) { SchedGrid S; S.init(192, 22, G, c, 0, 0, 4); Gemm g{(const bf16_t*)(ws + O_X1B), (const bf16_t*)(ws + O_WGU), 1024}; EpiFFN E{(bf16_t*)(ws + O_ACT), RS + 2 * RS_STRIDE}; gemm_phase(lds, g, S, E); }
  if constexpr (PH == 9) { SchedGridRev S; S.init(192, 4, G, c); Gemm g{(const bf16_t*)(ws + O_ACT), (const bf16_t*)(ws + O_WD), 2816}; EpiX2 E{(bf16_t*)(ws + O_X1B), RS + 3 * RS_STRIDE}; gemm_phase(lds, g, S, E); }
  if constexpr (PH == 10) phase_final(p);
}


#define XB_TMO      128
#define XB_XCNT(j)  (256  + 64 * (j))
#define XB_XSUB(j)  (1280 + 64 * (j))
#define XB_XGEN(j)  (2304 + 64 * (j))
#define XB_TOP      3328
#define XB_TOPGEN   3392
#define XCD_BAR_WORDS 3456
#define XB_SPIN_CAP (1u << 18)
__device__ __forceinline__ unsigned xb_ld(unsigned* p)              { return __hip_atomic_load(p, __ATOMIC_RELAXED, __HIP_MEMORY_SCOPE_AGENT); }
__device__ __forceinline__ unsigned xb_add(unsigned* p, unsigned v) { return __hip_atomic_fetch_add(p, v, __ATOMIC_RELAXED, __HIP_MEMORY_SCOPE_AGENT); }
__device__ __forceinline__ unsigned xb_xcc_id() { return (unsigned)__builtin_amdgcn_s_getreg((3 << 11) | 20) & 0xFu; }
#define XB_SPIN(cond, bar) do { unsigned _sp = 0; while (cond) { __builtin_amdgcn_s_sleep(1); \
    if ((++_sp & 255u) == 0u) { if (xb_ld(&(bar)[XB_TMO])) break; if (_sp > XB_SPIN_CAP) { atomicAdd(&(bar)[XB_TMO], 1u); break; } } } } while (0)
struct XcdBarrier { unsigned* bar; unsigned x; volatile LAS unsigned* st; };
__device__ __forceinline__ XcdBarrier xcd_barrier_post(unsigned* bar, volatile LAS unsigned* st) {
  XcdBarrier b; b.bar = bar; b.x = xb_xcc_id(); b.st = st;
  if (threadIdx.x == 0) (void)xb_add(&bar[XB_XCNT(b.x)], 1u);
  return b;
}
__device__ __forceinline__ void xcd_barrier_complete(unsigned* bar, unsigned x, unsigned& nloc, unsigned& nx) {
  const unsigned G = gridDim.x * gridDim.y * gridDim.z;
  unsigned sum, cnt, mine, sp = 0u;
  for (;;) {
    sum = 0u; cnt = 0u; mine = 0u;
#pragma unroll
    for (unsigned j = 0; j < 16; ++j) { const unsigned c = xb_ld(&bar[XB_XCNT(j)]); sum += c; cnt += (c > 0u) ? 1u : 0u; mine = (j == x) ? c : mine; }
    if (sum == G) break;
    __builtin_amdgcn_s_sleep(1);
    if ((++sp & 255u) == 0u) { if (xb_ld(&bar[XB_TMO])) break; if (sp > XB_SPIN_CAP) { atomicAdd(&bar[XB_TMO], 1u); break; } }
  }
  nloc = mine > 0u ? mine : 1u; nx = cnt > 0u ? cnt : 1u;
}
__device__ __forceinline__ void xcd_barrier(const XcdBarrier& b) {
  asm volatile("s_waitcnt vmcnt(0)" ::: "memory");
  __syncthreads();
  if (threadIdx.x == 0) {
    unsigned* bar = b.bar;
    __builtin_amdgcn_s_waitcnt(0);
    unsigned nloc = b.st[0], nx = b.st[1];
    if (nloc == 0u) { xcd_barrier_complete(bar, b.x, nloc, nx); b.st[0] = nloc; b.st[1] = nx; }
    const unsigned old = xb_add(&bar[XB_XSUB(b.x)], 1u);
    const unsigned gen = old / nloc;
    if (old + 1u == (gen + 1u) * nloc) {
      __builtin_amdgcn_fence(__ATOMIC_RELEASE, "agent");
      asm volatile("s_waitcnt vmcnt(0)" ::: "memory");
      const unsigned og = xb_add(&bar[XB_TOP], 1u);
      const unsigned tg = og / nx;
      if (og + 1u == (tg + 1u) * nx) xb_add(&bar[XB_TOPGEN], 1u);
      else XB_SPIN(xb_ld(&bar[XB_TOPGEN]) == tg, bar);
      __builtin_amdgcn_fence(__ATOMIC_ACQUIRE, "agent");
      xb_add(&bar[XB_XGEN(b.x)], 1u);
      asm volatile("s_waitcnt vmcnt(0)" ::: "memory");
    } else {
      XB_SPIN(xb_ld(&bar[XB_XGEN(b.x)]) == gen, bar);
      __builtin_amdgcn_fence(__ATOMIC_ACQUIRE, "agent");
      asm volatile("s_waitcnt vmcnt(0)" ::: "memory");
    }
  }
  __syncthreads();
}

constexpr int NPHASE = 11;
constexpr size_t LDS_BYTES = STAGE_BYTES;

#if MK_SINGLE
__global__ __launch_bounds__(512, 2) void mega_kernel(Params p) {
  extern __shared__ __attribute__((aligned(16))) unsigned char smem[];
  cg::grid_group grid = cg::this_grid();
  __shared__ uint4 xb_words;
  if (threadIdx.x == 0) xb_words = make_uint4(0u, 0u, 0u, 0u);
  __syncthreads();
  const XcdBarrier xb = xcd_barrier_post((unsigned*)(p.ws + O_BAR), (volatile LAS unsigned*)&xb_words);
#ifndef MK_MASK
#define MK_MASK 0x3fff
#endif
#define RP(n) if constexpr ((MK_MASK >> n) & 1) run_phase<n>(p, smem)
  RP(0); grid.sync();
  RP(1); xcd_barrier(xb);
  RP(2); xcd_barrier(xb);
  RP(3); xcd_barrier(xb);
  RP(4); RP(11); RP(12); xcd_barrier(xb);
  RP(5); xcd_barrier(xb);
  RP(6); xcd_barrier(xb);
  RP(7); xcd_barrier(xb);
  RP(8); xcd_barrier(xb);
  RP(9); xcd_barrier(xb);
  RP(10);
#undef RP
}
#else
template <int PH> __global__ __launch_bounds__(512, 2) void phase_kernel(Params p) {
  extern __shared__ __attribute__((aligned(16))) unsigned char smem[];
  run_phase<PH>(p, smem);
}

template <int PH> static void launch_phase(const Params& p, int grid, hipStream_t stream) {
  static bool attr = false;
  if (!attr) { hipFuncSetAttribute((const void*)phase_kernel<PH>, hipFuncAttributeMaxDynamicSharedMemorySize, (int)LDS_BYTES); attr = true; }
  hipLaunchKernelGGL(phase_kernel<PH>, dim3(grid), dim3(512), LDS_BYTES, stream, p);
}
#endif

extern "C" void kernel_launch(void* const* d_in, const int* in_sizes, int n_in, void* d_out, int out_size, void* d_ws, size_t ws_size, hipStream_t stream) {
  if (n_in != 17 || ws_size < WS_NEED || out_size != TOK * 1024) { fprintf(stderr, "kernel_launch: unexpected shapes (n_in %d ws %zu out %d)\n", n_in, ws_size, out_size); return; }
  Params p{};
  p.x_prompt = (const float*)d_in[0]; p.x_sample = (const float*)d_in[1]; p.meta = (const float*)d_in[2]; p.norm1_g = (const float*)d_in[3]; p.w_in = (const float*)d_in[4];
  p.q_norm_g = (const float*)d_in[5]; p.kv_norm_g = (const float*)d_in[6]; p.w_uq = (const float*)d_in[7]; p.w_ukv = (const float*)d_in[8]; p.w_fo = (const float*)d_in[9];
  p.w_ao = (const float*)d_in[10]; p.w_o = (const float*)d_in[11]; p.norm2_g = (const float*)d_in[12]; p.w_gate = (const float*)d_in[13]; p.w_up = (const float*)d_in[14];
  p.w_down = (const float*)d_in[15]; p.final_g = (const float*)d_in[16]; p.out = (float*)d_out; p.ws = (unsigned char*)d_ws;
#if MK_SINGLE
  static int grid_blocks = 0;
  if (!grid_blocks) {
    int dev = 0, cus = 0, per_cu = 0; hipGetDevice(&dev); hipDeviceGetAttribute(&cus, hipDeviceAttributeMultiprocessorCount, dev);
    hipFuncSetAttribute((const void*)mega_kernel, hipFuncAttributeMaxDynamicSharedMemorySize, (int)LDS_BYTES);
    hipOccupancyMaxActiveBlocksPerMultiprocessor(&per_cu, mega_kernel, 512, LDS_BYTES);
    if (per_cu < 1) per_cu = 1;
    grid_blocks = cus * 1;
  }
  (void)hipMemsetAsync((char*)d_ws + O_BAR, 0, 3456 * 4, stream);
  void* args[] = {&p};
  hipError_t e = hipLaunchCooperativeKernel((const void*)mega_kernel, dim3(grid_blocks), dim3(512), args, LDS_BYTES, stream);
  if (e != hipSuccess) fprintf(stderr, "cooperative launch failed: %s (grid %d)\n", hipGetErrorString(e), grid_blocks);
#else
  const int grid = 256;
  launch_phase<0>(p, grid, stream); launch_phase<1>(p, grid, stream); launch_phase<2>(p, grid, stream); launch_phase<3>(p, grid, stream);
  launch_phase<4>(p, grid, stream); launch_phase<11>(p, grid, stream); launch_phase<12>(p, grid, stream); launch_phase<5>(p, grid, stream); launch_phase<6>(p, grid, stream); launch_phase<7>(p, grid, stream);
  launch_phase<8>(p, grid, stream); launch_phase<9>(p, grid, stream); launch_phase<10>(p, grid, stream);
#endif
}
```

```cpp
#include <hip/hip_runtime.h>
#include <hip/hip_cooperative_groups.h>
#include <cstdio>
#include <cstdint>
namespace cg = cooperative_groups;

#ifndef DBG
#define DBG 0
#define DBGZ(u) false
#endif
#ifndef MK_SINGLE
#define MK_SINGLE 1
#endif

#define LAS __attribute__((address_space(3)))
typedef unsigned short bf16_t;
typedef short bf16x8 __attribute__((ext_vector_type(8)));
typedef short s16x4 __attribute__((ext_vector_type(4)));
typedef float f32x4 __attribute__((ext_vector_type(4)));
typedef float f32x16 __attribute__((ext_vector_type(16)));
typedef unsigned u32x4 __attribute__((ext_vector_type(4)));
typedef unsigned u32x2 __attribute__((ext_vector_type(2)));

constexpr int TOK = 49152;
constexpr int NMETA = 16;
constexpr float EPS = 1e-6f;
constexpr float ATT_SCALE = 0.07216878364870322f;
constexpr int TH = 0, TM = 192, TC = 193, TS = 299, TWZ = 405, TWP = 417, XROWS = 421 * 256;
constexpr size_t O_ROPE = 0;
constexpr size_t O_RS   = 2101248;
constexpr size_t RS_STRIDE = 49408;
constexpr size_t O_WUQ  = O_RS + 4 * RS_STRIDE * 4;
constexpr size_t O_WUKV = O_WUQ + 1572864;
constexpr size_t O_WFO  = O_WUKV + 1048576;
constexpr size_t O_WAO  = O_WFO + 1048576;
constexpr size_t O_WO   = O_WAO + 2097152;
constexpr size_t O_WGU  = O_WO + 2097152;
constexpr size_t O_WD   = O_WGU + 11534336;
constexpr size_t O_X    = 28311552;
constexpr size_t O_BAR  = O_WD + 5767168;
static_assert(O_BAR + 3456 * 4 <= O_X, "small region");
constexpr size_t SZ_X   = (size_t)XROWS * 2048;
constexpr size_t O_GA   = O_X + SZ_X;
constexpr size_t O_KR   = O_GA + 100663296;
constexpr size_t O_CQ   = O_KR + 6455296;
constexpr size_t O_CKV  = O_CQ + 50331648;
constexpr size_t O_PTP  = O_CKV + 25296896;
constexpr size_t O_PTS  = O_PTP + 35651584;
constexpr size_t O_V    = O_PTP;
constexpr size_t WS_NEED = O_V + 103284736;
constexpr size_t O_DAP  = O_X;
constexpr size_t O_DAS  = O_X + 20054016;
constexpr size_t O_STASH = O_X + 100663296;
constexpr size_t O_QN   = O_X;
constexpr size_t O_KN   = O_X + 100663296;
constexpr size_t O_X1B  = O_CQ;
constexpr size_t O_ACT  = O_X;
constexpr size_t OO_GB = 0, OO_QR = 100663296, OO_YF = 150994944;

struct Params {
  const float *x_prompt, *x_sample, *meta, *norm1_g, *w_in, *q_norm_g, *kv_norm_g, *w_uq, *w_ukv, *w_fo, *w_ao, *w_o, *norm2_g, *w_gate, *w_up, *w_down, *final_g;
  float* out; unsigned char* ws;
};

typedef __bf16 bf16x2_t __attribute__((ext_vector_type(2)));
typedef float f32x2_t __attribute__((ext_vector_type(2)));
__device__ __forceinline__ unsigned cvt_pk_bf16(float lo, float hi) { f32x2_t v = {lo, hi}; bf16x2_t r = __builtin_convertvector(v, bf16x2_t); return __builtin_bit_cast(unsigned, r); }
__device__ __forceinline__ int tid_fresh() { int t = threadIdx.x; asm volatile("" : "+v"(t)); return t; }
__device__ __forceinline__ float bf_lo(unsigned w) { return __uint_as_float(w << 16); }
__device__ __forceinline__ float bf_hi(unsigned w) { return __uint_as_float(w & 0xffff0000u); }
__host__ __device__ __forceinline__ int perm32(int rho) { const int n = rho >> 4, i = rho & 15; return 8 * (i >> 2) + 4 * n + (i & 3); }
__host__ __device__ __forceinline__ int permP(int v) { return (v & ~31) + perm32(v & 31); }
__host__ __device__ __forceinline__ int ropeslot(int s) { return 32 * ((s >> 4) & 1) + 16 * (s >> 5) + (s & 15); }
__device__ __forceinline__ int tok_seq(int t) { return t < 32768 ? (t >> 12) : 8 + ((t - 32768) >> 13); }
__device__ __forceinline__ int tok_pos(int t) { return t < 32768 ? (t & 4095) : ((t - 32768) & 8191); }
__device__ __forceinline__ int seq_S(int q) { return q < 8 ? 4096 : 8192; }
__device__ __forceinline__ int seq_tb(int q) { return q < 8 ? q * 4096 : 32768 + (q - 8) * 8192; }
__device__ __forceinline__ int seq_kvb(int q) { return q < 8 ? q * 4224 : 33792 + (q - 8) * 8320; }
__device__ __forceinline__ int tok_kvrow(int t) { return t < 32768 ? (t >> 12) * 4224 + (t & 4095) : 33792 + ((t - 32768) >> 13) * 8320 + ((t - 32768) & 8191); }
__device__ __forceinline__ float sigmoidf_(float x) { return __builtin_amdgcn_rcpf(1.f + __expf(-x)); }
__device__ __forceinline__ u32x4 pack8(f32x4 a, f32x4 b) { u32x4 w; w.x = cvt_pk_bf16(a[0], a[1]); w.y = cvt_pk_bf16(a[2], a[3]); w.z = cvt_pk_bf16(b[0], b[1]); w.w = cvt_pk_bf16(b[2], b[3]); return w; }
__device__ __forceinline__ u32x2 pack4(f32x4 a) { u32x2 w; w.x = cvt_pk_bf16(a[0], a[1]); w.y = cvt_pk_bf16(a[2], a[3]); return w; }
__device__ __forceinline__ float dot4(f32x4 a) { return a[0] * a[0] + a[1] * a[1] + a[2] * a[2] + a[3] * a[3]; }
__device__ __forceinline__ float red_fq(float s) { s += __shfl_xor(s, 16); s += __shfl_xor(s, 32); return s; }

constexpr int BM = 256, BK = 64, HALF = 128, HTB = HALF * BK * 2, STAGE_BYTES = 8 * HTB, NXCD = 8, WGM = 8;
__device__ __forceinline__ int lds_byte(int r, int c) { const int st = (r >> 4) * 2 + (c >> 5), rr = r & 15, cc = c & 31, ob = rr * 64 + cc * 2; return st * 1024 + (ob ^ (((ob >> 9) & 1) << 5)); }
__device__ __forceinline__ void stage_rc(int b, int& R, int& C) { const int st = b / 1024, sb = b % 1024, swz = sb ^ (((sb >> 9) & 1) << 5); R = (st >> 1) * 16 + swz / 64; C = (st & 1) * 32 + (swz % 64) / 2; }
struct Unit { int pm, pn; };
struct Gemm { const bf16_t* A; const bf16_t* Bt; int K; };

struct SchedGrid {
  int nM, nN, nwg, G, c, pm0, pn0, wgm;
  __device__ void init(int nM_, int nN_, int G_, int c_, int pm0_ = 0, int pn0_ = 0, int wgm_ = WGM) { nM = nM_; nN = nN_; nwg = nM * nN; G = G_; c = c_; pm0 = pm0_; pn0 = pn0_; wgm = wgm_; }
  __device__ bool map(int L, Unit& u) const {
    if (L >= nwg) return false;
    int wgid = L; { const int q = nwg / NXCD, r = nwg % NXCD, xcd = wgid % NXCD, off = wgid / NXCD; wgid = (xcd < r ? xcd * (q + 1) : r * (q + 1) + (xcd - r) * q) + off; }
    const int nig = wgm * nN, gid = wgid / nig, fm = gid * wgm, gsz = (nM - fm) < wgm ? (nM - fm) : wgm;
    u.pm = pm0 + fm + ((wgid % nig) % gsz); u.pn = pn0 + (wgid % nig) / gsz; return true;
  }
  __device__ bool next(int i, Unit& u) const { return map(i * G + c, u); }
};
struct SchedGridRev : SchedGrid {
  __device__ bool next(int i, Unit& u) const { if (!map(i * G + c, u)) return false; u.pm = pm0 + nM - 1 - (u.pm - pm0); return true; }
};
struct SchedP2 {
  SchedGrid z; int G, c;
  __device__ void init(int G_, int c_) { G = G_; c = c_; z.init(192, 12, G_, c_, TH, TWZ, 4); }
  __device__ bool next(int i, Unit& u) const {
    const int L = i * G + c;
    if (L < 2304) return z.map(L, u);
    if (L < 2306) { u.pm = TM; u.pn = TWZ + 2 + (L - 2304); return true; }
    if (L < 2730) { const int idx = L - 2306, a = idx & 3, j = idx >> 2; u.pm = TWP + a; u.pn = (a < 2 ? TC : TS) + j; return true; }
    return false;
  }
};

template <class Epi, class Sched>
__device__ __forceinline__ void gemm_phase(LAS unsigned char* lds, const Gemm g, const Sched& S, const Epi& E) {
  const int tid = tid_fresh(), wid = __builtin_amdgcn_readfirstlane(tid >> 6), lane = tid & 63, wr = wid >> 2, wc = wid & 3, fr = lane & 15, fq = lane >> 4;
  const int K = g.K, nt = K / BK;
  unsigned voffA[2];
#pragma unroll
  for (int i = 0; i < 2; ++i) { int R, C; stage_rc(tid * 16 + i * 8192, R, C); voffA[i] = (unsigned)(R * K + C) * 2u; }
  const size_t kstep = (size_t)(BK * 2);
  const size_t hstep = (size_t)HALF * K * 2;
  const size_t tstep = 2 * hstep;
  const unsigned ldsw = (unsigned)wid * 1024u;
  const int aoff = lds_byte(wr * 64 + fr, fq * 8), boff = lds_byte(wc * 32 + fr, fq * 8);
#define PG8_SA(b, h) (((b) * 2 + (h)) * HTB)
#define PG8_SB(b, h) ((4 + (b) * 2 + (h)) * HTB)
#define PG8_STAGE(bufoff, gbase) do { _Pragma("unroll") for (int _i = 0; _i < 2; ++_i) \
    __builtin_amdgcn_global_load_lds((const unsigned*)((const char*)(gbase) + voffA[_i]), (LAS unsigned*)(lds + (bufoff) + ldsw + _i * 8192), 16, 0, 0); } while (0)
#define PG8_LDA(dst, b, h) do { _Pragma("unroll") for (int m = 0; m < 4; ++m) _Pragma("unroll") for (int k = 0; k < 2; ++k) dst[m][k] = *(const LAS bf16x8*)(lds + PG8_SA(b, h) + aoff + m * 2048 + k * 1024); } while (0)
#define PG8_LDB(dst, b, h) do { _Pragma("unroll") for (int n = 0; n < 2; ++n) _Pragma("unroll") for (int k = 0; k < 2; ++k) dst[n][k] = *(const LAS bf16x8*)(lds + PG8_SB(b, h) + boff + n * 2048 + k * 1024); } while (0)
#define PG8_MMA(ai, bj, At, Bt) do { __builtin_amdgcn_s_setprio(1); _Pragma("unroll") for (int m = 0; m < 4; ++m) _Pragma("unroll") for (int n = 0; n < 2; ++n) _Pragma("unroll") for (int k = 0; k < 2; ++k) \
    acc[ai][bj][m][n] = __builtin_amdgcn_mfma_f32_16x16x32_bf16(Bt[n][k], At[m][k], acc[ai][bj][m][n], 0, 0, 0); __builtin_amdgcn_s_setprio(0); } while (0)
#define PG8_WAIT_V(n) asm volatile("s_waitcnt vmcnt(" #n ")" ::: "memory")
#define PG8_WAIT_L(n) asm volatile("s_waitcnt lgkmcnt(" #n ")" ::: "memory")
#define PG8_BAR __builtin_amdgcn_s_barrier()
#define PG8_SCHED __builtin_amdgcn_sched_barrier(0)
  Unit cur, nxt; int ui = 0;
  if (!S.next(0, cur)) return;
  f32x4 acc[2][2][4][2];
#pragma unroll
  for (int a = 0; a < 2; ++a)
#pragma unroll
    for (int b = 0; b < 2; ++b)
#pragma unroll
      for (int m = 0; m < 4; ++m)
#pragma unroll
        for (int n = 0; n < 2; ++n) acc[a][b][m][n] = (f32x4){0.f, 0.f, 0.f, 0.f};
  bf16x8 At[4][2], B0[2][2], B1[2][2];
  const char* cA = (const char*)g.A + (size_t)cur.pm * tstep; const char* cB = (const char*)g.Bt + (size_t)cur.pn * tstep;
  PG8_STAGE(PG8_SB(0, 0), cB); PG8_STAGE(PG8_SA(0, 0), cA); PG8_STAGE(PG8_SB(0, 1), cB + hstep); PG8_STAGE(PG8_SA(0, 1), cA + hstep);
  if (wr == 1) PG8_BAR;
  PG8_WAIT_V(4); PG8_BAR;
  PG8_STAGE(PG8_SB(1, 0), cB + kstep); PG8_STAGE(PG8_SA(1, 0), cA + kstep); PG8_STAGE(PG8_SB(1, 1), cB + hstep + kstep);
  PG8_WAIT_V(6); PG8_BAR;
  for (;;) {
    const bool has_next = S.next(ui + 1, nxt);
    const char* nA = has_next ? (const char*)g.A + (size_t)nxt.pm * tstep : cA; const char* nB = has_next ? (const char*)g.Bt + (size_t)nxt.pn * tstep : cB;
    for (int t = 0; t < nt; t += 2) {
      const bool last = (t == nt - 2);
      const char* a1 = cA + (size_t)(t + 1) * kstep;
      const char* a2 = last ? nA : cA + (size_t)(t + 2) * kstep; const char* b2 = last ? nB : cB + (size_t)(t + 2) * kstep;
      const char* a3 = a2 + kstep; const char* b3 = b2 + kstep;
      PG8_LDB(B0, 0, 0); PG8_SCHED; PG8_LDA(At, 0, 0); PG8_STAGE(PG8_SA(1, 1), a1 + hstep);
      PG8_WAIT_L(8); PG8_BAR; PG8_WAIT_L(0); PG8_MMA(0, 0, At, B0); PG8_BAR; PG8_SCHED;
      PG8_LDB(B1, 0, 1); PG8_STAGE(PG8_SB(0, 0), b2);
      PG8_BAR; PG8_WAIT_L(0); PG8_MMA(0, 1, At, B1); PG8_BAR;
      PG8_LDA(At, 0, 1); PG8_STAGE(PG8_SA(0, 0), a2);
      PG8_BAR; PG8_WAIT_L(0); PG8_MMA(1, 0, At, B0); PG8_BAR; PG8_SCHED;
      PG8_STAGE(PG8_SB(0, 1), b2 + hstep);
      PG8_WAIT_V(6); PG8_BAR; PG8_MMA(1, 1, At, B1); PG8_BAR;
      PG8_LDB(B0, 1, 0); PG8_SCHED; PG8_LDA(At, 1, 0); PG8_STAGE(PG8_SA(0, 1), a2 + hstep);
      PG8_WAIT_L(8); PG8_BAR; PG8_WAIT_L(0); PG8_MMA(0, 0, At, B0); PG8_BAR; PG8_SCHED;
      PG8_LDB(B1, 1, 1); PG8_STAGE(PG8_SB(1, 0), b3);
      PG8_BAR; PG8_WAIT_L(0); PG8_MMA(0, 1, At, B1); PG8_BAR;
      PG8_LDA(At, 1, 1); PG8_STAGE(PG8_SA(1, 0), a3);
      PG8_BAR; PG8_WAIT_L(0); PG8_MMA(1, 0, At, B0); PG8_BAR; PG8_SCHED;
      PG8_STAGE(PG8_SB(1, 1), b3 + hstep);
      PG8_WAIT_V(6); PG8_BAR; PG8_MMA(1, 1, At, B1); PG8_BAR;
    }
    E(acc, cur, wr, wc, fr, fq);
    if (!has_next) break;
#pragma unroll
    for (int a = 0; a < 2; ++a)
#pragma unroll
      for (int b = 0; b < 2; ++b)
#pragma unroll
        for (int m = 0; m < 4; ++m)
#pragma unroll
          for (int n = 0; n < 2; ++n) acc[a][b][m][n] = (f32x4){0.f, 0.f, 0.f, 0.f};
    cur = nxt; cA = nA; cB = nB; ++ui;
  }
  PG8_WAIT_V(0);
  if (wr == 0) PG8_BAR;
  PG8_BAR;
#undef PG8_SA
#undef PG8_SB
#undef PG8_STAGE
#undef PG8_LDA
#undef PG8_LDB
#undef PG8_MMA
#undef PG8_WAIT_V
#undef PG8_WAIT_L
#undef PG8_BAR
#undef PG8_SCHED
}

typedef const f32x4 (&AccRef)[2][2][4][2];

struct EpiZ {
  unsigned char* ws; unsigned char* outb;
  __device__ __forceinline__ void operator()(AccRef acc, const Unit& u, int wr, int wc, int fr, int fq) const {
    if (u.pm >= TWP) {
      const int a = u.pm - TWP, is_sin = a >> 1; const int j = u.pn - (is_sin ? TS : TC);
      int q, lt, Lk, rowlen; bf16_t* base;
      if (j < 72) { q = j / 9; lt = j - q * 9; Lk = 2176; rowlen = 2176; base = (bf16_t*)(ws + O_PTP) + (size_t)(is_sin * 4096 + q * 512) * 2176; }
      else { const int jj = j - 72; q = jj / 17; lt = jj - q * 17; Lk = 4224; rowlen = 4224; base = (bf16_t*)(ws + O_PTS) + (size_t)(is_sin * 1024 + q * 512) * 4224; }
      const int ch0 = (a & 1) * 256 + wr * 64 + fr, l0 = lt * 256 + wc * 32 + 4 * fq;
#pragma unroll
      for (int ai = 0; ai < 2; ++ai)
#pragma unroll
        for (int m = 0; m < 4; ++m) { bf16_t* rowp = base + (size_t)(ch0 + ai * 128 + m * 16) * rowlen + l0;
#pragma unroll
          for (int bj = 0; bj < 2; ++bj) if (lt * 256 + bj * 128 < Lk) {
#pragma unroll
            for (int n = 0; n < 2; ++n) *(u32x2*)(rowp + bj * 128 + n * 16) = pack4(acc[ai][bj][m][n]); } }
      return;
    }
    const int sec = u.pn - TWZ; const int row0 = u.pm * 256 + wr * 64 + fr;
    if (sec < 3) {
      bf16_t* dst; int ld, colb; float* rs;
      if (sec < 2) { dst = (bf16_t*)(ws + O_CQ); ld = 512; colb = sec * 256; rs = (float*)(ws + O_RS); }
      else { dst = (bf16_t*)(ws + O_CKV); ld = 256; colb = 0; rs = (float*)(ws + O_RS) + RS_STRIDE; }
#pragma unroll
      for (int ai = 0; ai < 2; ++ai)
#pragma unroll
        for (int m = 0; m < 4; ++m) { const int row = row0 + ai * 128 + m * 16; const bool valid = row < TOK + NMETA; float ss = 0.f;
#pragma unroll
          for (int bj = 0; bj < 2; ++bj) { ss += dot4(acc[ai][bj][m][0]) + dot4(acc[ai][bj][m][1]);
            if (valid) *(u32x4*)(dst + (size_t)row * ld + colb + bj * 128 + wc * 32 + 8 * fq) = pack8(acc[ai][bj][m][0], acc[ai][bj][m][1]); }
          ss = red_fq(ss); if (fq == 0 && valid) unsafeAtomicAdd(rs + row, ss); }
    } else if (sec == 3) {
      if (wc < 2) {
        const float* rope = (const float*)(ws + O_ROPE); bf16_t* KR = (bf16_t*)(ws + O_KR); const int j = 16 * wc + 4 * fq;
#pragma unroll
        for (int ai = 0; ai < 2; ++ai)
#pragma unroll
          for (int m = 0; m < 4; ++m) { const int row = row0 + ai * 128 + m * 16; if (row >= TOK + NMETA) continue;
            const int pos = row < TOK ? NMETA + tok_pos(row) : row - TOK;
            const f32x4 cs = *(const f32x4*)(rope + pos * 64 + j), sn = *(const f32x4*)(rope + pos * 64 + 32 + j);
            const f32x4 x1 = acc[ai][0][m][0], x2 = acc[ai][0][m][1];
            const u32x2 o1 = pack4(x1 * cs - x2 * sn), o2 = pack4(x2 * cs + x1 * sn);
            if (row < TOK) { bf16_t* d = KR + (size_t)tok_kvrow(row) * 64 + j; *(u32x2*)d = o1; *(u32x2*)(d + 32) = o2; }
            else { for (int q = 0; q < 10; ++q) { bf16_t* d = KR + (size_t)(seq_kvb(q) + seq_S(q) + (row - TOK)) * 64 + j; *(u32x2*)d = o1; *(u32x2*)(d + 32) = o2; } } }
      }
    } else {
      bf16_t* dst = sec < 8 ? (bf16_t*)(ws + O_GA) : (bf16_t*)(outb + OO_GB); const int colb = ((sec - 4) & 3) * 256 + wc * 32 + 8 * fq;
#pragma unroll
      for (int ai = 0; ai < 2; ++ai)
#pragma unroll
        for (int m = 0; m < 4; ++m) { const int row = row0 + ai * 128 + m * 16;
#pragma unroll
          for (int bj = 0; bj < 2; ++bj) { f32x4 a = acc[ai][bj][m][0], b = acc[ai][bj][m][1];
#pragma unroll
            for (int i = 0; i < 4; ++i) { a[i] = sigmoidf_(a[i]); b[i] = sigmoidf_(b[i]); }
            __builtin_nontemporal_store(pack8(a, b), (u32x4*)(dst + (size_t)row * 1024 + colb + bj * 128)); } }
    }
  }
};

struct SchedPair {
  int nMt, nNt, G, c, mode;
  __device__ bool next(int i, Unit& u) const {
    if ((G & 7) == 0) { const int x = c & 7, pl = (i >> 1) * (G >> 3) + (c >> 3);
      if (mode == 0) { if (pl >= 18) return false; u.pm = pl % 9; u.pn = 2 * x + pl / 9; }
      else { const int lo = (x >> 2) ? 9 : 0, cnt = (x >> 2) ? 8 : 9; if (pl >= cnt) return false; u.pm = lo + pl; u.pn = x & 3; } }
    else { const int pair = (i >> 1) * G + c; if (pair >= nMt * nNt) return false; u.pm = pair % nMt; u.pn = pair / nMt; }
    if (i & 1) { u.pm += nMt; u.pn += nNt; } return true;
  }
};
struct EpiDFT {
  bf16_t* YF; float* stash; int tb, S, nMt, nNt;
  __device__ __forceinline__ void operator()(AccRef acc, const Unit& u, int wr, int wc, int fr, int fq) const {
    const int tid = (wr * 4 + wc) * 64 + fq * 16 + fr; float* st = stash + (size_t)blockIdx.x * (512 * 128) + tid * 128;
    if (u.pm < nMt) {
#pragma unroll
      for (int ai = 0; ai < 2; ++ai)
#pragma unroll
        for (int bj = 0; bj < 2; ++bj)
#pragma unroll
          for (int m = 0; m < 4; ++m)
#pragma unroll
            for (int n = 0; n < 2; ++n) *(f32x4*)(st + (((ai * 2 + bj) * 4 + m) * 2 + n) * 4) = acc[ai][bj][m][n];
      return;
    }
    const int pn = u.pn - nNt, b = pn >> 1, col0 = (pn & 1) * 256 + wc * 32 + 8 * fq, half = (S + NMETA) >> 1; const int r0 = (u.pm - nMt) * 256 + wr * 64 + fr;
#pragma unroll
    for (int ai = 0; ai < 2; ++ai)
#pragma unroll
      for (int m = 0; m < 4; ++m) { const int k = r0 + ai * 128 + m * 16 + 1; if (k > half) continue;
#pragma unroll
        for (int bj = 0; bj < 2; ++bj) { const f32x4 c0 = *(const f32x4*)(st + (((ai * 2 + bj) * 4 + m) * 2 + 0) * 4), c1 = *(const f32x4*)(st + (((ai * 2 + bj) * 4 + m) * 2 + 1) * 4);
          const f32x4 s0 = acc[ai][bj][m][0], s1 = acc[ai][bj][m][1];
          if (k >= NMETA) *(u32x4*)(YF + (size_t)(tb + b * S + k - NMETA) * 512 + col0 + bj * 128) = pack8(c0 - s0, c1 - s1);
          if (k < half) *(u32x4*)(YF + (size_t)(tb + b * S + S - k) * 512 + col0 + bj * 128) = pack8(c0 + s0, c1 + s1);
          __builtin_amdgcn_sched_barrier(0); } }
  }
};

struct EpiQ {
  bf16_t* QN; bf16_t* QR; const float* rs; const float* rope;
  __device__ __forceinline__ void operator()(AccRef acc, const Unit& u, int wr, int wc, int fr, int fq) const {
    const int row0 = u.pm * 256 + wr * 64 + fr;
#pragma unroll
    for (int ai = 0; ai < 2; ++ai)
#pragma unroll
      for (int m = 0; m < 4; ++m) { const int row = row0 + ai * 128 + m * 16; const float rq = rsqrtf(rs[row] * (1.f / 512.f) + EPS); const int pos = NMETA + tok_pos(row);
#pragma unroll
        for (int bj = 0; bj < 2; ++bj) { const int beta = 4 * u.pn + 2 * bj + (wc >> 1), head = beta / 3, part = beta - 3 * head;
          if (part < 2) *(u32x4*)(QN + ((size_t)row * 8 + head) * 128 + part * 64 + (wc & 1) * 32 + 8 * fq) = pack8(acc[ai][bj][m][0] * rq, acc[ai][bj][m][1] * rq);
          else { const int j = 16 * (wc & 1) + 4 * fq; const f32x4 cs = *(const f32x4*)(rope + pos * 64 + j), sn = *(const f32x4*)(rope + pos * 64 + 32 + j);
            const f32x4 x1 = acc[ai][bj][m][0] * rq, x2 = acc[ai][bj][m][1] * rq; bf16_t* d = QR + ((size_t)row * 8 + head) * 64 + j;
            *(u32x2*)d = pack4(x1 * cs - x2 * sn); *(u32x2*)(d + 32) = pack4(x2 * cs + x1 * sn); } } }
  }
};

struct EpiKV {
  bf16_t* KN; bf16_t* V; const float* rs;
  __device__ __forceinline__ void operator()(AccRef acc, const Unit& u, int wr, int wc, int fr, int fq) const {
    const int row0 = u.pm * 256 + wr * 64 + fr, head = u.pn, col = wc * 32 + 8 * fq;
#pragma unroll
    for (int ai = 0; ai < 2; ++ai)
#pragma unroll
      for (int m = 0; m < 4; ++m) { const int row = row0 + ai * 128 + m * 16; if (row >= TOK + NMETA) continue;
        const float rk = rsqrtf(rs[row] * (1.f / 256.f) + EPS);
        const u32x4 kk = pack8(acc[ai][0][m][0] * rk, acc[ai][0][m][1] * rk), vv = pack8(acc[ai][1][m][0] * rk, acc[ai][1][m][1] * rk);
        if (row < TOK) { const size_t o = ((size_t)tok_kvrow(row) * 8 + head) * 128 + col; *(u32x4*)(KN + o) = kk; *(u32x4*)(V + o) = vv; }
        else { for (int q = 0; q < 10; ++q) { const size_t o = ((size_t)(seq_kvb(q) + seq_S(q) + (row - TOK)) * 8 + head) * 128 + col; *(u32x4*)(KN + o) = kk; *(u32x4*)(V + o) = vv; } } }
  }
};

struct EpiT1 {
  bf16_t* GA;
  __device__ __forceinline__ void operator()(AccRef acc, const Unit& u, int wr, int wc, int fr, int fq) const {
    const int row0 = u.pm * 256 + wr * 64 + fr, col0 = u.pn * 256 + wc * 32 + 8 * fq;
#pragma unroll
    for (int ai = 0; ai < 2; ++ai)
#pragma unroll
      for (int m = 0; m < 4; ++m) { bf16_t* rowp = GA + (size_t)(row0 + ai * 128 + m * 16) * 1024 + col0;
#pragma unroll
        for (int bj = 0; bj < 2; ++bj) { u32x4 g = *(const u32x4*)(rowp + bj * 128); const f32x4 a = acc[ai][bj][m][0], b = acc[ai][bj][m][1];
#if DBG == 10
          g = (u32x4){0x3f003f00u, 0x3f003f00u, 0x3f003f00u, 0x3f003f00u};
#endif
          const f32x4 ra = {bf_lo(g.x) * a[0], bf_hi(g.x) * a[1], bf_lo(g.y) * a[2], bf_hi(g.y) * a[3]}, rb = {bf_lo(g.z) * b[0], bf_hi(g.z) * b[1], bf_lo(g.w) * b[2], bf_hi(g.w) * b[3]};
#if DBG == 1
          *(u32x4*)(rowp + bj * 128) = (u32x4){0u, 0u, 0u, 0u};
#elif DBG >= 5
          *(u32x4*)(rowp + bj * 128) = DBGZ(u) ? (u32x4){0u, 0u, 0u, 0u} : pack8(ra, rb);
#else
          *(u32x4*)(rowp + bj * 128) = pack8(ra, rb);
#endif
          } }
  }
};
struct EpiMrg {
  bf16_t* GA; const bf16_t* GB;
  __device__ __forceinline__ void operator()(AccRef acc, const Unit& u, int wr, int wc, int fr, int fq) const {
    const int row0 = u.pm * 256 + wr * 64 + fr, col0 = u.pn * 256 + wc * 32 + 8 * fq;
#pragma unroll
    for (int ai = 0; ai < 2; ++ai)
#pragma unroll
      for (int m = 0; m < 4; ++m) { const size_t o = (size_t)(row0 + ai * 128 + m * 16) * 1024 + col0;
#pragma unroll
        for (int bj = 0; bj < 2; ++bj) { const u32x4 t = *(const u32x4*)(GA + o + bj * 128), g = *(const u32x4*)(GB + o + bj * 128); const f32x4 a = acc[ai][bj][m][0], b = acc[ai][bj][m][1];
          const f32x4 ra = {bf_lo(t.x) + bf_lo(g.x) * a[0], bf_hi(t.x) + bf_hi(g.x) * a[1], bf_lo(t.y) + bf_lo(g.y) * a[2], bf_hi(t.y) + bf_hi(g.y) * a[3]};
          const f32x4 rb = {bf_lo(t.z) + bf_lo(g.z) * b[0], bf_hi(t.z) + bf_hi(g.z) * b[1], bf_lo(t.w) + bf_lo(g.w) * b[2], bf_hi(t.w) + bf_hi(g.w) * b[3]};
#if DBG == 2
          *(u32x4*)(GA + o + bj * 128) = t;
#else
          *(u32x4*)(GA + o + bj * 128) = pack8(ra, rb);
#endif
          } }
  }
};
struct EpiX1 {
  const float* xp; const float* xs; bf16_t* X1B; float* rs;
  __device__ __forceinline__ void operator()(AccRef acc, const Unit& u, int wr, int wc, int fr, int fq) const {
    const int row0 = u.pm * 256 + wr * 64 + fr, col0 = u.pn * 256 + wc * 32 + 8 * fq;
#pragma unroll
    for (int ai = 0; ai < 2; ++ai)
#pragma unroll
      for (int m = 0; m < 4; ++m) { const int row = row0 + ai * 128 + m * 16; const float* xr = (row < 32768 ? xp + (size_t)row * 1024 : xs + (size_t)(row - 32768) * 1024) + col0; float ss = 0.f;
#pragma unroll
        for (int bj = 0; bj < 2; ++bj) { const f32x4 a = acc[ai][bj][m][0] + __builtin_nontemporal_load((const f32x4*)(xr + bj * 128)), b = acc[ai][bj][m][1] + __builtin_nontemporal_load((const f32x4*)(xr + bj * 128 + 4));
          ss += dot4(a) + dot4(b); const size_t o = (size_t)row * 1024 + col0 + bj * 128;
          *(u32x4*)(X1B + o) = pack8(a, b); }
        ss = red_fq(ss); if (fq == 0) unsafeAtomicAdd(rs + row, ss); }
  }
};
struct EpiFFN {
  bf16_t* ACT; const float* rs;
  __device__ __forceinline__ void operator()(AccRef acc, const Unit& u, int wr, int wc, int fr, int fq) const {
    const int row0 = u.pm * 256 + wr * 64 + fr, col0 = u.pn * 128 + wc * 32 + 8 * fq;
#pragma unroll
    for (int ai = 0; ai < 2; ++ai)
#pragma unroll
      for (int m = 0; m < 4; ++m) { const int row = row0 + ai * 128 + m * 16; const float r2 = rsqrtf(rs[row] * (1.f / 1024.f) + EPS); f32x4 o[2];
#pragma unroll
        for (int n = 0; n < 2; ++n)
#pragma unroll
          for (int i = 0; i < 4; ++i) { const float g = acc[ai][0][m][n][i] * r2, up = acc[ai][1][m][n][i] * r2; o[n][i] = g * sigmoidf_(g) * up; }
        *(u32x4*)(ACT + (size_t)row * 2816 + col0) = pack8(o[0], o[1]); }
  }
};
struct EpiX2 {
  bf16_t* X; float* rs;
  __device__ __forceinline__ void operator()(AccRef acc, const Unit& u, int wr, int wc, int fr, int fq) const {
    const int row0 = u.pm * 256 + wr * 64 + fr, col0 = u.pn * 256 + wc * 32 + 8 * fq;
#pragma unroll
    for (int ai = 0; ai < 2; ++ai)
#pragma unroll
      for (int m = 0; m < 4; ++m) { const int row = row0 + ai * 128 + m * 16; float ss = 0.f;
#pragma unroll
        for (int bj = 0; bj < 2; ++bj) { bf16_t* p = X + (size_t)row * 1024 + col0 + bj * 128; const u32x4 t = *(const u32x4*)p; const f32x4 a0 = acc[ai][bj][m][0], b0 = acc[ai][bj][m][1];
          const f32x4 a = {bf_lo(t.x) + a0[0], bf_hi(t.x) + a0[1], bf_lo(t.y) + a0[2], bf_hi(t.y) + a0[3]}, b = {bf_lo(t.z) + b0[0], bf_hi(t.z) + b0[1], bf_lo(t.w) + b0[2], bf_hi(t.w) + b0[3]};
          ss += dot4(a) + dot4(b); *(u32x4*)p = pack8(a, b); }
        ss = red_fq(ss); if (fq == 0) unsafeAtomicAdd(rs + row, ss); }
  }
};

constexpr int KVBLK = 64;
constexpr int SHM_V = 16384, SHM_KN = 64 * 272, SHM_KR = 64 * 144;
constexpr int A_V = 0, A_KN = 2 * SHM_V, A_KR = A_KN + 2 * SHM_KN, A_WS = A_KR + 2 * SHM_KR, A_QR = A_WS + 2048;
static_assert(A_QR + 8 * 4608 <= 131072, "attention LDS");
#define KNSWZ(row, colB) ((row) * 272 + (colB))
#define KRSWZ(row, colB) ((row) * 144 + (colB))
#define SBAR() __builtin_amdgcn_sched_barrier(0)
constexpr float THR = 8.f;
__device__ __forceinline__ int crow(int r, int hi) { return (r & 3) + 8 * (r >> 2) + 4 * hi; }
__device__ __forceinline__ void partialSM(f32x16& p0, f32x16& p1, float& m_reg, float& mn, float& alpha) {
  constexpr float C = ATT_SCALE * 1.4426950408889634f;
  float pmax = p0[0];
#pragma unroll
  for (int r = 1; r < 16; ++r) pmax = fmaxf(pmax, p0[r]);
#pragma unroll
  for (int r = 0; r < 16; ++r) pmax = fmaxf(pmax, p1[r]);
  { auto rr = __builtin_amdgcn_permlane32_swap(__float_as_uint(pmax), __float_as_uint(pmax), false, false);
    pmax = fmaxf(__uint_as_float(rr[0]), __uint_as_float(rr[1])); }
  if (__builtin_expect(__all(pmax - m_reg <= THR / ATT_SCALE), 1)) { mn = m_reg; alpha = 1.f; }
  else { mn = fmaxf(m_reg, pmax); alpha = __builtin_amdgcn_exp2f((m_reg - mn) * C); m_reg = mn; }
  const float mnC = -mn * C;
#pragma unroll
  for (int r = 0; r < 16; ++r) p0[r] = fmaf(p0[r], C, mnC);
#pragma unroll
  for (int r = 0; r < 16; ++r) p1[r] = fmaf(p1[r], C, mnC);
#pragma unroll
  for (int r = 0; r < 16; ++r) p0[r] = __builtin_amdgcn_exp2f(p0[r]);
}
__device__ __forceinline__ void finishSM(f32x16& p0, f32x16& p1, float alpha, float& l_reg, bf16x8& pa0, bf16x8& pa1, bf16x8& pa2, bf16x8& pa3) {
#pragma unroll
  for (int r = 0; r < 16; ++r) p1[r] = __builtin_amdgcn_exp2f(p1[r]);
  float ps = 0;
#pragma unroll
  for (int r = 0; r < 16; ++r) ps += p0[r];
#pragma unroll
  for (int r = 0; r < 16; ++r) ps += p1[r];
  { auto rr = __builtin_amdgcn_permlane32_swap(__float_as_uint(ps), __float_as_uint(ps), false, false);
    ps = __uint_as_float(rr[0]) + __uint_as_float(rr[1]); }
  l_reg = l_reg * alpha + ps;
#define PK4(P, BASE, OUT) do { unsigned a0 = cvt_pk_bf16(P[BASE + 0], P[BASE + 1]), a1 = cvt_pk_bf16(P[BASE + 2], P[BASE + 3]);   \
    unsigned b0 = cvt_pk_bf16(P[BASE + 4], P[BASE + 5]), b1 = cvt_pk_bf16(P[BASE + 6], P[BASE + 7]);                              \
    auto r0 = __builtin_amdgcn_permlane32_swap(a0, b0, false, false); auto r1 = __builtin_amdgcn_permlane32_swap(a1, b1, false, false); \
    u32x4 w = {r0[0], r1[0], r0[1], r1[1]}; OUT = *reinterpret_cast<bf16x8*>(&w); } while (0)
  PK4(p0, 0, pa0); PK4(p0, 8, pa1); PK4(p1, 0, pa2); PK4(p1, 8, pa3);
#undef PK4
}
__device__ __forceinline__ void qkt(f32x16& p0, f32x16& p1, const char* Kn, const char* Kr, const bf16x8* qr, const char* Qrl, int r32, int hi) {
  p0 = f32x16{}; p1 = f32x16{};
#pragma unroll
  for (int d0 = 0; d0 < 8; ++d0) { const int cb = (d0 * 16 + hi * 8) * 2;
    const bf16x8 b0 = *reinterpret_cast<const bf16x8*>(Kn + KNSWZ(r32, cb));
    const bf16x8 b1 = *reinterpret_cast<const bf16x8*>(Kn + KNSWZ(32 + r32, cb));
    p0 = __builtin_amdgcn_mfma_f32_32x32x16_bf16(b0, qr[d0], p0, 0, 0, 0);
    p1 = __builtin_amdgcn_mfma_f32_32x32x16_bf16(b1, qr[d0], p1, 0, 0, 0); }
#pragma unroll
  for (int d0 = 0; d0 < 4; ++d0) { const int cb = (d0 * 16 + hi * 8) * 2;
    const bf16x8 b0 = *reinterpret_cast<const bf16x8*>(Kr + KRSWZ(r32, cb));
    const bf16x8 b1 = *reinterpret_cast<const bf16x8*>(Kr + KRSWZ(32 + r32, cb));
    const bf16x8 qx = *reinterpret_cast<const bf16x8*>(Qrl + KRSWZ(r32, cb));
    p0 = __builtin_amdgcn_mfma_f32_32x32x16_bf16(b0, qx, p0, 0, 0, 0);
    p1 = __builtin_amdgcn_mfma_f32_32x32x16_bf16(b1, qx, p1, 0, 0, 0); }
}
__device__ __forceinline__ int v_st(int k, int c) { const int kk = (k & ~0xC) | ((k & 4) << 1) | ((k & 8) >> 1); return ((kk >> 3) * 4 + (c >> 5)) * 512 + ((kk & 7) * 32 + (c & 31)) * 2; }
__device__ __forceinline__ int v_rd_base(int lane) { return ((lane & 3) << 3) | (((lane >> 2) & 3) << 6) | (((lane >> 4) & 1) << 5) | (((lane >> 5) & 1) << 8); }
constexpr int v_rd_off(int d0, int ks, int half) { return d0 * 512 + ks * 4096 + half * 2048; }
template <int OFF> __device__ __forceinline__ s16x4 tr_read(int vb) {
  s16x4 r; asm volatile("ds_read_b64_tr_b16 %0, %1 offset:%2" : "=&v"(r) : "v"(vb), "i"(OFF) : "memory"); return r;
}
template <int D0> __device__ __forceinline__ void pv_one(f32x16& od, int vb, bf16x8 pa0, bf16x8 pa1, bf16x8 pa2, bf16x8 pa3) {
  const s16x4 l0 = tr_read<v_rd_off(D0, 0, 0)>(vb), h0 = tr_read<v_rd_off(D0, 0, 1)>(vb), l1 = tr_read<v_rd_off(D0, 1, 0)>(vb), h1 = tr_read<v_rd_off(D0, 1, 1)>(vb);
  const s16x4 l2 = tr_read<v_rd_off(D0, 2, 0)>(vb), h2 = tr_read<v_rd_off(D0, 2, 1)>(vb), l3 = tr_read<v_rd_off(D0, 3, 0)>(vb), h3 = tr_read<v_rd_off(D0, 3, 1)>(vb);
  asm volatile("s_waitcnt lgkmcnt(0)" ::: "memory"); SBAR();
#define PK(L, H) (bf16x8){L[0], L[1], L[2], L[3], H[0], H[1], H[2], H[3]}
  od = __builtin_amdgcn_mfma_f32_32x32x16_bf16(pa0, PK(l0, h0), od, 0, 0, 0);
  od = __builtin_amdgcn_mfma_f32_32x32x16_bf16(pa1, PK(l1, h1), od, 0, 0, 0);
  od = __builtin_amdgcn_mfma_f32_32x32x16_bf16(pa2, PK(l2, h2), od, 0, 0, 0);
  od = __builtin_amdgcn_mfma_f32_32x32x16_bf16(pa3, PK(l3, h3), od, 0, 0, 0);
#undef PK
}
__device__ __forceinline__ void pv_d0(f32x16* o, int vb, bf16x8 pa0, bf16x8 pa1, bf16x8 pa2, bf16x8 pa3) {
  pv_one<0>(o[0], vb, pa0, pa1, pa2, pa3); pv_one<1>(o[1], vb, pa0, pa1, pa2, pa3); pv_one<2>(o[2], vb, pa0, pa1, pa2, pa3); pv_one<3>(o[3], vb, pa0, pa1, pa2, pa3);
}

__device__ __forceinline__ void attn_body(const bf16_t* __restrict__ Qn, const bf16_t* __restrict__ Qr, const bf16_t* __restrict__ Kn, const bf16_t* __restrict__ Kr,
                                          const bf16_t* __restrict__ Vh, bf16_t* __restrict__ Ob, int NTP, char* lds) {
  const int tid = tid_fresh(), wid = tid >> 6, lane = tid & 63, r32 = lane & 31, hi = lane >> 5;
  char* V_lds = lds + A_V; char* KN_lds = lds + A_KN; char* KR_lds = lds + A_KR;
  float* wsl = (float*)(lds + A_WS) + wid * 64; float* li_l = wsl; float* al_l = wsl + 32;
  float m_reg = -1e30f, l_reg = 0; f32x16 o[4] = {}; bf16x8 qr[8]; char* Qrl = lds + A_QR + wid * 4608;
  { const bf16_t* Qw = Qn + (size_t)(wid * 32 + r32) * 1024 + hi * 8;
#pragma unroll
    for (int d0 = 0; d0 < 8; ++d0) qr[d0] = *reinterpret_cast<const bf16x8*>(Qw + d0 * 16);
    const bf16_t* Qw2 = Qr + (size_t)(wid * 32 + r32) * 512 + hi * 8;
#pragma unroll
    for (int d0 = 0; d0 < 4; ++d0) *reinterpret_cast<bf16x8*>(Qrl + KRSWZ(r32, (d0 * 16 + hi * 8) * 2)) = *reinterpret_cast<const bf16x8*>(Qw2 + d0 * 16); }
  const int sr = tid >> 4, sc = (tid & 15) * 8, vst0 = v_st(sr, sc), vst1 = v_st(32 + sr, sc);
  const int krr = tid >> 3, krc = (tid & 7) * 8;
  const int vb0 = (int)(uintptr_t)(LAS char*)V_lds + v_rd_base(lane);
  struct { bf16x8 vs0, vs1, ks0, ks1, kr; } sr_[1];
#define SLOAD(i, k0) do { sr_[i].vs0 = *(const bf16x8*)(&Vh[(size_t)((k0) + sr) * 1024 + sc]); sr_[i].vs1 = *(const bf16x8*)(&Vh[(size_t)((k0) + 32 + sr) * 1024 + sc]); \
    sr_[i].ks0 = *(const bf16x8*)(&Kn[(size_t)((k0) + sr) * 1024 + sc]); sr_[i].ks1 = *(const bf16x8*)(&Kn[(size_t)((k0) + 32 + sr) * 1024 + sc]); \
    sr_[i].kr = *(const bf16x8*)(&Kr[(size_t)((k0) + krr) * 64 + krc]); } while (0)
#define SWRITE(b, i) do { *(bf16x8*)(V_lds + (b) * SHM_V + vst0) = sr_[i].vs0; *(bf16x8*)(V_lds + (b) * SHM_V + vst1) = sr_[i].vs1; const int kc = sc * 2; \
    *(bf16x8*)(KN_lds + (b) * SHM_KN + KNSWZ(sr, kc)) = sr_[i].ks0; *(bf16x8*)(KN_lds + (b) * SHM_KN + KNSWZ(32 + sr, kc)) = sr_[i].ks1; \
    *(bf16x8*)(KR_lds + (b) * SHM_KR + KRSWZ(krr, krc * 2)) = sr_[i].kr; } while (0)
#define SWAIT() asm volatile("s_waitcnt vmcnt(0)" ::: "memory")
#define RESC(a) do { if (__any((a) < 1.f)) { if (hi == 0) al_l[r32] = (a); asm volatile("s_waitcnt lgkmcnt(0)" ::: "memory"); \
    _Pragma("unroll") for (int d = 0; d < 4; ++d) _Pragma("unroll") for (int r = 0; r < 16; ++r) o[d][r] *= al_l[crow(r, hi)]; } } while (0)
  f32x16 pA0, pA1, pB0, pB1; float mnA, mnB, alA, alB; bf16x8 pa0, pa1, pa2, pa3;
  constexpr int SE = 0, SO = 0;
  SLOAD(SE, 0); asm volatile("s_waitcnt vmcnt(0)" ::: "memory"); SWRITE(0, SE); __syncthreads();
  qkt(pA0, pA1, KN_lds, KR_lds, qr, Qrl, r32, hi); partialSM(pA0, pA1, m_reg, mnA, alA);
  SLOAD(SO, KVBLK);
  SWAIT(); SWRITE(1, SO); __syncthreads();
  for (int j = 1; j < NTP; j += 2) {
    SBAR(); qkt(pB0, pB1, KN_lds + SHM_KN, KR_lds + SHM_KR, qr, Qrl, r32, hi);
    finishSM(pA0, pA1, alA, l_reg, pa0, pa1, pa2, pa3); SBAR();
    SLOAD(SE, (j + 1) * KVBLK); SBAR();
    pv_d0(o, vb0, pa0, pa1, pa2, pa3); partialSM(pB0, pB1, m_reg, mnB, alB);
    __syncthreads(); SWAIT(); SWRITE(0, SE);
    RESC(alB); __syncthreads();
    SBAR(); qkt(pA0, pA1, KN_lds, KR_lds, qr, Qrl, r32, hi);
    if (j + 2 == NTP) {
#pragma unroll
      for (int r = 8; r < 16; ++r) pA0[r] = -1e30f;
#pragma unroll
      for (int r = 0; r < 16; ++r) pA1[r] = -1e30f;
    }
    finishSM(pB0, pB1, alB, l_reg, pa0, pa1, pa2, pa3); SBAR();
    SLOAD(SO, (j + 2) * KVBLK); SBAR();
    pv_d0(o, vb0 + SHM_V, pa0, pa1, pa2, pa3); partialSM(pA0, pA1, m_reg, mnA, alA);
    __syncthreads(); SWAIT(); SWRITE(1, SO);
    RESC(alA); __syncthreads();
  }
  finishSM(pA0, pA1, alA, l_reg, pa0, pa1, pa2, pa3); SBAR();
  pv_d0(o, vb0, pa0, pa1, pa2, pa3);
  if (hi == 0) li_l[r32] = l_reg; asm volatile("s_waitcnt lgkmcnt(0)" ::: "memory");
  float rli[16];
#pragma unroll
  for (int r = 0; r < 16; ++r) rli[r] = __builtin_amdgcn_rcpf(li_l[crow(r, hi)]);
  bf16_t* Ow = Ob + (size_t)(wid * 32) * 1024;
#pragma unroll
  for (int r = 0; r < 16; ++r) { const int orow = crow(r, hi);
#pragma unroll
    for (int d0 = 0; d0 < 4; ++d0) Ow[(size_t)orow * 1024 + d0 * 32 + r32] = (bf16_t)(cvt_pk_bf16(o[d0][r] * rli[r], 0.f) & 0xffffu); }
  asm volatile("s_waitcnt vmcnt(0)" ::: "memory");
  __syncthreads();
#undef SLOAD
#undef SWRITE
#undef SWAIT
#undef RESC
}

__device__ __forceinline__ float wave_sum(float v) {
#pragma unroll
  for (int o = 32; o > 0; o >>= 1) v += __shfl_xor(v, o);
  return v;
}

__device__ void conv_w(int mode, bf16_t* dst, int N, int K, const Params& p, int gtid, int gsize) {
  const int total = N * (K >> 3);
  for (int idx = gtid; idx < total; idx += gsize) {
    const int v = idx % N, k8 = idx / N;
    const float* src = nullptr; const float* scale = nullptr; int ld = 0, col = 0;
    switch (mode) {
      case 0: { ld = 3392; src = p.w_in; const int t = v >> 8;
        if (t < 2) col = 512 + permP(v); else if (t == 2) col = 1024 + permP(v - 512);
        else if (t == 3) { if (v - 768 < 64) col = 1280 + ropeslot(v - 768); else src = nullptr; }
        else if (t < 8) col = 1344 + permP(v - 1024); else col = 2368 + permP(v - 2048); } break;
      case 1: { ld = 1536; src = p.w_uq; scale = p.q_norm_g; const int beta = v >> 6; col = (beta % 3 < 2) ? permP(v) : (v & ~63) + ropeslot(v & 63); } break;
      case 2: ld = 2048; src = p.w_ukv; scale = p.kv_norm_g; col = permP(v); break;
      case 3: ld = 1024; src = p.w_fo; col = permP(v); break;
      case 4: ld = 1024; src = p.w_ao; col = permP(v); break;
      case 5: ld = 1024; src = p.w_o; col = permP(v); break;
      case 6: { ld = 2816; scale = p.norm2_g; const int t = v >> 8, half = (v >> 7) & 1, w = v & 127; src = half ? p.w_up : p.w_gate; col = t * 128 + permP(w); } break;
      default: ld = 1024; src = p.w_down; col = permP(v); break;
    }
    float f[8];
#pragma unroll
    for (int kk = 0; kk < 8; ++kk) { const int k = k8 * 8 + kk; f[kk] = src ? src[(size_t)k * ld + col] * (scale ? scale[k] : 1.f) : 0.f; }
    u32x4 w; w.x = cvt_pk_bf16(f[0], f[1]); w.y = cvt_pk_bf16(f[2], f[3]); w.z = cvt_pk_bf16(f[4], f[5]); w.w = cvt_pk_bf16(f[6], f[7]);
    *(u32x4*)(dst + (size_t)v * K + k8 * 8) = w;
  }
}

__device__ void phase_prep(const Params& p, unsigned char* smem) {
  const int gtid = blockIdx.x * 512 + threadIdx.x, gsize = gridDim.x * 512;
  unsigned char* ws = p.ws;
  { float* rs = (float*)(ws + O_RS); for (int i = gtid; i < 4 * (int)RS_STRIDE; i += gsize) rs[i] = 0.f; }
#if DBG == 9
  { u32x4* ga = (u32x4*)(ws + O_GA); for (int i = gtid; i < 100663296 / 16; i += gsize) ga[i] = (u32x4){0u, 0u, 0u, 0u}; }
#endif
  { float* rope = (float*)(ws + O_ROPE);
    for (int i = gtid; i < 8208 * 32; i += gsize) { const int pos = i >> 5, j = i & 31;
      const float inv = 1.0f / exp2f((float)(2 * j) * (1.f / 64.f) * 13.287712379549449f);
      const float ang = (float)pos * inv; const double rev = (double)ang * 0.15915494309189535; const float fr = (float)(rev - rint(rev));
      rope[pos * 64 + j] = __builtin_amdgcn_cosf(fr); rope[pos * 64 + 32 + j] = __builtin_amdgcn_sinf(fr); } }
  { bf16_t* X = (bf16_t*)(ws + O_X); const int lane = threadIdx.x & 63; const int gw = gtid >> 6, nw = gsize >> 6;
    f32x4 g1[4];
#pragma unroll
    for (int i = 0; i < 4; ++i) g1[i] = *(const f32x4*)(p.norm1_g + 4 * (lane + 64 * i));
    for (int it = gw; it < 27136; it += nw) {
      int q, lp; if (it < 18432) { q = it / 2304; lp = it - q * 2304; } else { const int r = it - 18432; q = 8 + r / 4352; lp = r - (q - 8) * 4352; }
      const int S = seq_S(q), L = S + NMETA, half = L >> 1;
      bf16_t* hc = X + (size_t)(TC * 256 + it) * 1024; bf16_t* hs = X + (size_t)(TS * 256 + it) * 1024;
      if (lp > half) {
#pragma unroll
        for (int i = 0; i < 4; ++i) { *(u32x2*)(hc + 4 * (lane + 64 * i)) = (u32x2){0u, 0u}; *(u32x2*)(hs + 4 * (lane + 64 * i)) = (u32x2){0u, 0u}; }
        continue;
      }
      const bool single = (lp == 0) || (lp == half);
      const int l1 = lp, l2 = single ? lp : L - lp;
      const float* xa = l1 < NMETA ? p.meta + (size_t)l1 * 1024 : (q < 8 ? p.x_prompt + ((size_t)q * 4096 + (l1 - NMETA)) * 1024 : p.x_sample + ((size_t)(q - 8) * 8192 + (l1 - NMETA)) * 1024);
      const float* xb = l2 < NMETA ? p.meta + (size_t)l2 * 1024 : (q < 8 ? p.x_prompt + ((size_t)q * 4096 + (l2 - NMETA)) * 1024 : p.x_sample + ((size_t)(q - 8) * 8192 + (l2 - NMETA)) * 1024);
      f32x4 v1[4], v2[4]; float s1 = 0.f, s2 = 0.f;
#pragma unroll
      for (int i = 0; i < 4; ++i) { v1[i] = __builtin_nontemporal_load((const f32x4*)(xa + 4 * (lane + 64 * i))); v2[i] = __builtin_nontemporal_load((const f32x4*)(xb + 4 * (lane + 64 * i))); }
#pragma unroll
      for (int i = 0; i < 4; ++i) { s1 += dot4(v1[i]); s2 += dot4(v2[i]); }
#pragma unroll
      for (int o = 32; o > 0; o >>= 1) { s1 += __shfl_xor(s1, o); s2 += __shfl_xor(s2, o); }
      const float r1 = rsqrtf(s1 * (1.f / 1024.f) + EPS), r2 = rsqrtf(s2 * (1.f / 1024.f) + EPS);
#pragma unroll
      for (int i = 0; i < 4; ++i) { v1[i] = v1[i] * r1 * g1[i]; v2[i] = v2[i] * r2 * g1[i]; }
      bf16_t* h1 = nullptr; bf16_t* h2 = nullptr;
      if (l1 >= NMETA) h1 = X + (size_t)(seq_tb(q) + l1 - NMETA) * 1024; else if (q == 0) h1 = X + (size_t)(TM * 256 + l1) * 1024;
      if (!single) h2 = X + (size_t)(seq_tb(q) + l2 - NMETA) * 1024;
      if (h1) {
#pragma unroll
        for (int i = 0; i < 4; ++i) *(u32x2*)(h1 + 4 * (lane + 64 * i)) = pack4(v1[i]); }
      if (h2) {
#pragma unroll
        for (int i = 0; i < 4; ++i) *(u32x2*)(h2 + 4 * (lane + 64 * i)) = pack4(v2[i]); }
#pragma unroll
      for (int i = 0; i < 4; ++i) { const f32x4 c = single ? v1[i] : v1[i] + v2[i]; const f32x4 sn = single ? (f32x4){0.f, 0.f, 0.f, 0.f} : v1[i] - v2[i];
        *(u32x2*)(hc + 4 * (lane + 64 * i)) = pack4(c); *(u32x2*)(hs + 4 * (lane + 64 * i)) = pack4(sn); }
    }
  }
  conv_w(0, (bf16_t*)(ws + O_X) + (size_t)TWZ * 256 * 1024, 3072, 1024, p, gtid, gsize);
  { float* tw = (float*)smem; __syncthreads();
    if (threadIdx.x < 256) { const int j = threadIdx.x & 127; const float ph = (float)j * (1.f / 128.f); tw[threadIdx.x] = threadIdx.x < 128 ? __builtin_amdgcn_cosf(ph) : __builtin_amdgcn_sinf(ph); }
    __syncthreads();
    bf16_t* WP = (bf16_t*)(ws + O_X) + (size_t)TWP * 256 * 1024;
    for (int idx = gtid; idx < 1024 * 1024; idx += gsize) { const int v = idx & 1023, k = idx >> 10; const int is_sin = v >> 9, c = permP(v & 511), g = c >> 7, cp = c & 127;
      const float* wr = p.w_in + (size_t)k * 3392 + g * 128; const float* T = tw + is_sin * 128; float acc0 = 0.f, acc1 = 0.f; int j = 0;
#pragma unroll 8
      for (int c0 = 0; c0 < 128; c0 += 2) { acc0 = fmaf(wr[c0], T[j], acc0); j = (j + cp) & 127; acc1 = fmaf(wr[c0 + 1], T[j], acc1); j = (j + cp) & 127; }
      WP[(size_t)v * 1024 + k] = (bf16_t)(cvt_pk_bf16(acc0 + acc1, 0.f) & 0xffffu); } }
}

__device__ void phase_convw_late(const Params& p, int gtid, int gsize) {
  unsigned char* ws = p.ws;
  conv_w(1, (bf16_t*)(ws + O_WUQ), 1536, 512, p, gtid, gsize);
  conv_w(2, (bf16_t*)(ws + O_WUKV), 2048, 256, p, gtid, gsize);
  conv_w(3, (bf16_t*)(ws + O_WFO), 1024, 512, p, gtid, gsize);
  conv_w(4, (bf16_t*)(ws + O_WAO), 1024, 1024, p, gtid, gsize);
  conv_w(5, (bf16_t*)(ws + O_WO), 1024, 1024, p, gtid, gsize);
  conv_w(6, (bf16_t*)(ws + O_WGU), 5632, 1024, p, gtid, gsize);
  conv_w(7, (bf16_t*)(ws + O_WD), 1024, 2816, p, gtid, gsize);
}

template <int S, int LK, int MP>
__device__ __forceinline__ void dagen_grp(bf16_t* DA, bf16_t* tab) {
  constexpr int L = S + NMETA, half = L / 2, W8 = LK / 8, total = 2 * MP * W8;
  const int gtid = blockIdx.x * 512 + tid_fresh(), gsize = gridDim.x * 512;
  const float nrm = rsqrtf(128.f * (float)L), invL = 1.f / (float)L;
  __syncthreads();
  for (int m = threadIdx.x; m < L; m += 512) { const float ph = (float)m * invL;
    tab[m] = (bf16_t)(cvt_pk_bf16(__builtin_amdgcn_cosf(ph) * nrm, 0.f) & 0xffffu); tab[8208 + m] = (bf16_t)(cvt_pk_bf16(__builtin_amdgcn_sinf(ph) * nrm, 0.f) & 0xffffu); }
  __syncthreads();
  for (int idx = gtid; idx < total; idx += gsize) { const int r = idx / W8, c8 = idx - r * W8, part = r >= MP, k = r - part * MP + 1, lp0 = c8 * 8;
    int m = (k * lp0) % L; const bf16_t* T = tab + part * 8208; unsigned e[8];
#pragma unroll
    for (int j = 0; j < 8; ++j) { const int lp = lp0 + j; const bool valid = part ? (lp >= 1 && lp < half) : (lp <= half); e[j] = valid ? (unsigned)T[m] : 0u; m += k; m = m >= L ? m - L : m; }
    u32x4 w; w.x = e[0] | (e[1] << 16); w.y = e[2] | (e[3] << 16); w.z = e[4] | (e[5] << 16); w.w = e[6] | (e[7] << 16);
    *(u32x4*)(DA + (size_t)r * LK + lp0) = w; }
}
__device__ void phase_dagen(const Params& p, unsigned char* smem) {
  dagen_grp<4096, 2176, 2304>((bf16_t*)(p.ws + O_DAP), (bf16_t*)smem);
  dagen_grp<8192, 4224, 4352>((bf16_t*)(p.ws + O_DAS), (bf16_t*)smem);
}

__device__ void phase_attn(const Params& p, char* lds) {
  const int G = gridDim.x, c = blockIdx.x; const int cs = (G & 7) ? c : (c & 7) * (G >> 3) + (c >> 3);
  const bf16_t* QN = (const bf16_t*)(p.ws + O_QN); const bf16_t* QR = (const bf16_t*)((unsigned char*)p.out + OO_QR);
  const bf16_t* KN = (const bf16_t*)(p.ws + O_KN); const bf16_t* KR = (const bf16_t*)(p.ws + O_KR); const bf16_t* V = (const bf16_t*)(p.ws + O_V);
  for (int idx = cs; idx < 1536; idx += G) {
    int q, h, blk;
    if (idx < 512) { const int pair = idx >> 5; blk = idx & 31; q = 8 + (pair >> 3); h = pair & 7; }
    else { const int i2 = idx - 512, pair = i2 >> 4; blk = i2 & 15; q = pair >> 3; h = pair & 7; }
    const int S = seq_S(q); const size_t t0 = (size_t)seq_tb(q) + (size_t)blk * 256; const size_t kv0 = (size_t)seq_kvb(q);
    attn_body(QN + (t0 * 8 + h) * 128, QR + (t0 * 8 + h) * 64, KN + (kv0 * 8 + h) * 128, KR + kv0 * 64, V + (kv0 * 8 + h) * 128,
              (bf16_t*)(p.ws + O_QN) + (t0 * 8 + h) * 128, S / 64 + 1, lds);
  }
}

__device__ void phase_final(const Params& p) {
  const int lane = threadIdx.x & 63; const int gw = (blockIdx.x * 512 + threadIdx.x) >> 6, nw = (gridDim.x * 512) >> 6;
  const float* rs = (const float*)(p.ws + O_RS) + 3 * RS_STRIDE; const bf16_t* X2 = (const bf16_t*)(p.ws + O_X1B);
  f32x4 g[4];
#pragma unroll
  for (int i = 0; i < 4; ++i) g[i] = *(const f32x4*)(p.final_g + 4 * (lane + 64 * i));
  for (int t = gw; t < TOK; t += 2 * nw) { const int t2 = t + nw < TOK ? t + nw : t;
    const float ra = rsqrtf(rs[t] * (1.f / 1024.f) + EPS), rb = rsqrtf(rs[t2] * (1.f / 1024.f) + EPS);
    const bf16_t* xa = X2 + (size_t)t * 1024; const bf16_t* xb = X2 + (size_t)t2 * 1024; u32x2 wa[4], wb[4];
#pragma unroll
    for (int i = 0; i < 4; ++i) { wa[i] = *(const u32x2*)(xa + 4 * (lane + 64 * i)); wb[i] = *(const u32x2*)(xb + 4 * (lane + 64 * i)); }
#pragma unroll
    for (int i = 0; i < 4; ++i) { f32x4 v = {bf_lo(wa[i].x), bf_hi(wa[i].x), bf_lo(wa[i].y), bf_hi(wa[i].y)}; __builtin_nontemporal_store(v * ra * g[i], (f32x4*)(p.out + (size_t)t * 1024 + 4 * (lane + 64 * i))); }
    if (t2 != t) {
#pragma unroll
      for (int i = 0; i < 4; ++i) { f32x4 v = {bf_lo(wb[i].x), bf_hi(wb[i].x), bf_lo(wb[i].y), bf_hi(wb[i].y)}; __builtin_nontemporal_store(v * rb * g[i], (f32x4*)(p.out + (size_t)t2 * 1024 + 4 * (lane + 64 * i))); } } }
}

template <int PH>
__device__ __forceinline__ void run_phase(const Params& p, unsigned char* smem) {
  LAS unsigned char* lds = (LAS unsigned char*)smem; const int G = gridDim.x, c = blockIdx.x; unsigned char* ws = p.ws; unsigned char* outb = (unsigned char*)p.out;
  float* RS = (float*)(ws + O_RS);
  if constexpr (PH == 0) phase_prep(p, smem);
  if constexpr (PH == 1) { SchedP2 S; S.init(G, c); Gemm g{(const bf16_t*)(ws + O_X), (const bf16_t*)(ws + O_X), 1024}; EpiZ E{ws, outb}; gemm_phase(lds, g, S, E); }
  if constexpr (PH == 2) phase_dagen(p, smem);
  if constexpr (PH == 3) {
    const int hG = (G == 256) ? 112 : (G >> 1); float* stash = (float*)(ws + O_STASH);
    if (c < hG) { SchedPair S{17, 4, hG, c, 1}; Gemm g{(const bf16_t*)(ws + O_DAS), (const bf16_t*)(ws + O_PTS), 4224}; EpiDFT E{(bf16_t*)(outb + OO_YF), stash, 32768, 8192, 17, 4}; gemm_phase(lds, g, S, E); }
    else { SchedPair S{9, 16, G - hG, c - hG, 0}; Gemm g{(const bf16_t*)(ws + O_DAP), (const bf16_t*)(ws + O_PTP), 2176}; EpiDFT E{(bf16_t*)(outb + OO_YF), stash, 0, 4096, 9, 16}; gemm_phase(lds, g, S, E); }
    { int cg = c, cn = G; bool act = true;
      if (G == 256) { act = c >= hG; cg = c - hG; cn = G - hG; }
      if (act) phase_convw_late(p, cg * 512 + tid_fresh(), cn * 512); }
  }
  if constexpr (PH == 4) { SchedGrid S; S.init(192, 6, G, c); Gemm g{(const bf16_t*)(ws + O_CQ), (const bf16_t*)(ws + O_WUQ), 512}; EpiQ E{(bf16_t*)(ws + O_QN), (bf16_t*)(outb + OO_QR), RS, (const float*)(ws + O_ROPE)}; gemm_phase(lds, g, S, E); }
  if constexpr (PH == 11) { SchedGrid S; S.init(193, 8, G, (c + (G >> 1)) % G);
    Gemm g{(const bf16_t*)(ws + O_CKV), (const bf16_t*)(ws + O_WUKV), 256}; EpiKV E{(bf16_t*)(ws + O_KN), (bf16_t*)(ws + O_V), RS + RS_STRIDE}; gemm_phase(lds, g, S, E); }
  if constexpr (PH == 12) { SchedGrid S; S.init(192, 4, G, c); Gemm g{(const bf16_t*)(outb + OO_YF), (const bf16_t*)(ws + O_WFO), 512}; EpiT1 E{(bf16_t*)(ws + O_GA)}; gemm_phase(lds, g, S, E); }
  if constexpr (PH == 5) phase_attn(p, (char*)smem);
  if constexpr (PH == 6) { SchedGrid S; S.init(192, 4, G, c); Gemm g{(const bf16_t*)(ws + O_QN), (const bf16_t*)(ws + O_WAO), 1024}; EpiMrg E{(bf16_t*)(ws + O_GA), (const bf16_t*)(outb + OO_GB)}; gemm_phase(lds, g, S, E); }
  if constexpr (PH == 7) { SchedGrid S; S.init(192, 4, G, c); Gemm g{(const bf16_t*)(ws + O_GA), (const bf16_t*)(ws + O_WO), 1024}; EpiX1 E{p.x_prompt, p.x_sample, (bf16_t*)(ws + O_X1B), RS + 2 * RS_STRIDE}; gemm_phase(lds, g, S, E); }
  if constexpr (PH == 8) { SchedGrid S; S.init(192, 22, G, c, 0, 0, 4); Gemm g{(const bf16_t*)(ws + O_X1B), (const bf16_t*)(ws + O_WGU), 1024}; EpiFFN E{(bf16_t*)(ws + O_ACT), RS + 2 * RS_STRIDE}; gemm_phase(lds, g, S, E); }
  if constexpr (PH == 9) { SchedGridRev S; S.init(192, 4, G, c); Gemm g{(const bf16_t*)(ws + O_ACT), (const bf16_t*)(ws + O_WD), 2816}; EpiX2 E{(bf16_t*)(ws + O_X1B), RS + 3 * RS_STRIDE}; gemm_phase(lds, g, S, E); }
  if constexpr (PH == 10) phase_final(p);
}


#define XB_TMO      128
#define XB_XCNT(j)  (256  + 64 * (j))
#define XB_XSUB(j)  (1280 + 64 * (j))
#define XB_XGEN(j)  (2304 + 64 * (j))
#define XB_TOP      3328
#define XB_TOPGEN   3392
#define XCD_BAR_WORDS 3456
#define XB_SPIN_CAP (1u << 18)
__device__ __forceinline__ unsigned xb_ld(unsigned* p)              { return __hip_atomic_load(p, __ATOMIC_RELAXED, __HIP_MEMORY_SCOPE_AGENT); }
__device__ __forceinline__ unsigned xb_add(unsigned* p, unsigned v) { return __hip_atomic_fetch_add(p, v, __ATOMIC_RELAXED, __HIP_MEMORY_SCOPE_AGENT); }
__device__ __forceinline__ unsigned xb_xcc_id() { return (unsigned)__builtin_amdgcn_s_getreg((3 << 11) | 20) & 0xFu; }
#define XB_SPIN(cond, bar) do { unsigned _sp = 0; while (cond) { __builtin_amdgcn_s_sleep(1); \
    if ((++_sp & 255u) == 0u) { if (xb_ld(&(bar)[XB_TMO])) break; if (_sp > XB_SPIN_CAP) { atomicAdd(&(bar)[XB_TMO], 1u); break; } } } } while (0)
struct XcdBarrier { unsigned* bar; unsigned x; volatile LAS unsigned* st; };
__device__ __forceinline__ XcdBarrier xcd_barrier_post(unsigned* bar, volatile LAS unsigned* st) {
  XcdBarrier b; b.bar = bar; b.x = xb_xcc_id(); b.st = st;
  if (threadIdx.x == 0) (void)xb_add(&bar[XB_XCNT(b.x)], 1u);
  return b;
}
__device__ __forceinline__ void xcd_barrier_complete(unsigned* bar, unsigned x, unsigned& nloc, unsigned& nx) {
  const unsigned G = gridDim.x * gridDim.y * gridDim.z;
  unsigned sum, cnt, mine, sp = 0u;
  for (;;) {
    sum = 0u; cnt = 0u; mine = 0u;
#pragma unroll
    for (unsigned j = 0; j < 16; ++j) { const unsigned c = xb_ld(&bar[XB_XCNT(j)]); sum += c; cnt += (c > 0u) ? 1u : 0u; mine = (j == x) ? c : mine; }
    if (sum == G) break;
    __builtin_amdgcn_s_sleep(1);
    if ((++sp & 255u) == 0u) { if (xb_ld(&bar[XB_TMO])) break; if (sp > XB_SPIN_CAP) { atomicAdd(&bar[XB_TMO], 1u); break; } }
  }
  nloc = mine > 0u ? mine : 1u; nx = cnt > 0u ? cnt : 1u;
}
__device__ __forceinline__ void xcd_barrier(const XcdBarrier& b) {
  asm volatile("s_waitcnt vmcnt(0)" ::: "memory");
  __syncthreads();
  if (threadIdx.x == 0) {
    unsigned* bar = b.bar;
    __builtin_amdgcn_s_waitcnt(0);
    unsigned nloc = b.st[0], nx = b.st[1];
    if (nloc == 0u) { xcd_barrier_complete(bar, b.x, nloc, nx); b.st[0] = nloc; b.st[1] = nx; }
    const unsigned old = xb_add(&bar[XB_XSUB(b.x)], 1u);
    const unsigned gen = old / nloc;
    if (old + 1u == (gen + 1u) * nloc) {
      __builtin_amdgcn_fence(__ATOMIC_RELEASE, "agent");
      asm volatile("s_waitcnt vmcnt(0)" ::: "memory");
      const unsigned og = xb_add(&bar[XB_TOP], 1u);
      const unsigned tg = og / nx;
      if (og + 1u == (tg + 1u) * nx) xb_add(&bar[XB_TOPGEN], 1u);
      else XB_SPIN(xb_ld(&bar[XB_TOPGEN]) == tg, bar);
      __builtin_amdgcn_fence(__ATOMIC_ACQUIRE, "agent");
      xb_add(&bar[XB_XGEN(b.x)], 1u);
      asm volatile("s_waitcnt vmcnt(0)" ::: "memory");
    } else {
      XB_SPIN(xb_ld(&bar[XB_XGEN(b.x)]) == gen, bar);
      __builtin_amdgcn_fence(__ATOMIC_ACQUIRE, "agent");
      asm volatile("s_waitcnt vmcnt(0)" ::: "memory");
    }
  }
  __syncthreads();
}

constexpr int NPHASE = 11;
constexpr size_t LDS_BYTES = STAGE_BYTES;

#if MK_SINGLE
__global__ __launch_bounds__(512, 2) void mega_kernel(Params p) {
  extern __shared__ __attribute__((aligned(16))) unsigned char smem[];
  cg::grid_group grid = cg::this_grid();
  __shared__ uint4 xb_words;
  if (threadIdx.x == 0) xb_words = make_uint4(0u, 0u, 0u, 0u);
  __syncthreads();
  const XcdBarrier xb = xcd_barrier_post((unsigned*)(p.ws + O_BAR), (volatile LAS unsigned*)&xb_words);
#ifndef MK_MASK
#define MK_MASK 0x3fff
#endif
#define RP(n) if constexpr ((MK_MASK >> n) & 1) run_phase<n>(p, smem)
  RP(0); grid.sync();
  RP(1); xcd_barrier(xb);
  RP(2); xcd_barrier(xb);
  RP(3); xcd_barrier(xb);
  RP(12); RP(4); RP(11); xcd_barrier(xb);
  RP(5); xcd_barrier(xb);
  RP(6); xcd_barrier(xb);
  RP(7); xcd_barrier(xb);
  RP(8); xcd_barrier(xb);
  RP(9); xcd_barrier(xb);
  RP(10);
#undef RP
}
#else
template <int PH> __global__ __launch_bounds__(512, 2) void phase_kernel(Params p) {
  extern __shared__ __attribute__((aligned(16))) unsigned char smem[];
  run_phase<PH>(p, smem);
}

template <int PH> static void launch_phase(const Params& p, int grid, hipStream_t stream) {
  static bool attr = false;
  if (!attr) { hipFuncSetAttribute((const void*)phase_kernel<PH>, hipFuncAttributeMaxDynamicSharedMemorySize, (int)LDS_BYTES); attr = true; }
  hipLaunchKernelGGL(phase_kernel<PH>, dim3(grid), dim3(512), LDS_BYTES, stream, p);
}
#endif

extern "C" void kernel_launch(void* const* d_in, const int* in_sizes, int n_in, void* d_out, int out_size, void* d_ws, size_t ws_size, hipStream_t stream) {
  if (n_in != 17 || ws_size < WS_NEED || out_size != TOK * 1024) { fprintf(stderr, "kernel_launch: unexpected shapes (n_in %d ws %zu out %d)\n", n_in, ws_size, out_size); return; }
  Params p{};
  p.x_prompt = (const float*)d_in[0]; p.x_sample = (const float*)d_in[1]; p.meta = (const float*)d_in[2]; p.norm1_g = (const float*)d_in[3]; p.w_in = (const float*)d_in[4];
  p.q_norm_g = (const float*)d_in[5]; p.kv_norm_g = (const float*)d_in[6]; p.w_uq = (const float*)d_in[7]; p.w_ukv = (const float*)d_in[8]; p.w_fo = (const float*)d_in[9];
  p.w_ao = (const float*)d_in[10]; p.w_o = (const float*)d_in[11]; p.norm2_g = (const float*)d_in[12]; p.w_gate = (const float*)d_in[13]; p.w_up = (const float*)d_in[14];
  p.w_down = (const float*)d_in[15]; p.final_g = (const float*)d_in[16]; p.out = (float*)d_out; p.ws = (unsigned char*)d_ws;
#if MK_SINGLE
  static int grid_blocks = 0;
  if (!grid_blocks) {
    int dev = 0, cus = 0, per_cu = 0; hipGetDevice(&dev); hipDeviceGetAttribute(&cus, hipDeviceAttributeMultiprocessorCount, dev);
    hipFuncSetAttribute((const void*)mega_kernel, hipFuncAttributeMaxDynamicSharedMemorySize, (int)LDS_BYTES);
    hipOccupancyMaxActiveBlocksPerMultiprocessor(&per_cu, mega_kernel, 512, LDS_BYTES);
    if (per_cu < 1) per_cu = 1;
    grid_blocks = cus * 1;
  }
  (void)hipMemsetAsync((char*)d_ws + O_BAR, 0, 3456 * 4, stream);
  void* args[] = {&p};
  hipError_t e = hipLaunchCooperativeKernel((const void*)mega_kernel, dim3(grid_blocks), dim3(512), args, LDS_BYTES, stream);
  if (e != hipSuccess) fprintf(stderr, "cooperative launch failed: %s (grid %d)\n", hipGetErrorString(e), grid_blocks);
#else
  const int grid = 256;
  launch_phase<0>(p, grid, stream); launch_phase<1>(p, grid, stream); launch_phase<2>(p, grid, stream); launch_phase<3>(p, grid, stream);
  launch_phase<4>(p, grid, stream); launch_phase<11>(p, grid, stream); launch_phase<12>(p, grid, stream); launch_phase<5>(p, grid, stream); launch_phase<6>(p, grid, stream); launch_phase<7>(p, grid, stream);
  launch_phase<8>(p, grid, stream); launch_phase<9>(p, grid, stream); launch_phase<10>(p, grid, stream);
#endif
}
```
